# Optimizing an MI355X kernel written in HIP

```python
import jax, jax.numpy as jnp
from jax import lax
import numpy as np

D_MODEL = 2048
BATCH = 2
SEQ = 4096
DEPTH = 4
DEC_BATCH = 32
DEC_SEQ = 8
PAST_LEN = 16384
PAGE_SIZE = 128

A_HEADS = 16
A_KV_HEADS = 2
A_GROUP = A_HEADS // A_KV_HEADS
A_HEAD_DIM = 64
A_WIDTH = A_HEADS * A_HEAD_DIM
A_KV_WIDTH = A_KV_HEADS * A_HEAD_DIM
WINDOW = 128
CHUNK = 128
B_GROUPS = 4
B_WIDTH = D_MODEL - A_WIDTH
B_GROUP_DIM = B_WIDTH // B_GROUPS
EVEN_IN = 2 * A_WIDTH + 2 * A_KV_WIDTH + 3 * B_WIDTH
EVEN_OUT = A_WIDTH + B_WIDTH
R_HEADS = 8
R_KEY_DIM = D_MODEL // R_HEADS
R_VAL_DIM = 2 * R_KEY_DIM
R_K_WIDTH = R_HEADS * R_KEY_DIM
R_V_WIDTH = R_HEADS * R_VAL_DIM
R_CHUNK = 128
RET_IN = 2 * R_K_WIDTH + 2 * R_V_WIDTH
MEM_LEN = 256
X_HEADS = 4
X_HEAD_DIM = 128
X_WIDTH = X_HEADS * X_HEAD_DIM

N_ATTN_LAYERS = (DEPTH + 1) // 2
N_RET_LAYERS = DEPTH // 2
EPS = 1e-6
NEG_INF = -1e30
F32 = jnp.float32

kernel_name = 'hybrid_swa_gmlp_retention_step'


def rmsnorm(x, g):
    x32 = x.astype(F32)
    y = x32 * lax.rsqrt(jnp.mean(x32 * x32, axis=-1, keepdims=True) + EPS)
    return (y * g.astype(F32)).astype(x.dtype)


def standardize(x):
    x32 = x.astype(F32)
    xc = x32 - jnp.mean(x32, axis=-1, keepdims=True)
    return xc * lax.rsqrt(jnp.mean(xc * xc, axis=-1, keepdims=True) + EPS)


def alibi_slopes():
    return jnp.exp2(-8.0 * (jnp.arange(A_HEADS, dtype=F32) + 1.0) / A_HEADS)


def retention_log_decay():
    return jnp.log1p(-jnp.exp2(-5.0 - jnp.arange(R_HEADS, dtype=F32)))


def sink_window_attention(q, k, v, q_pos, k_pos, sinks):
    s = jnp.einsum('bnqkgd,bnskd->bnkgqs', q.astype(F32), k.astype(F32)) * (A_HEAD_DIM ** -0.5)
    dist = q_pos[:, :, None] - k_pos[:, None, :]
    valid = (dist >= 0) & (dist < WINDOW) & (k_pos[:, None, :] >= 0)
    slopes = alibi_slopes().reshape(A_KV_HEADS, A_GROUP)[None, None, :, :, None, None]
    s = jnp.where(valid[None, :, None, None], s - slopes * dist.astype(F32)[None, :, None, None], NEG_INF)
    sink = sinks.astype(F32).reshape(A_KV_HEADS, A_GROUP)[None, None, :, :, None, None]
    m = jnp.maximum(jnp.max(s, axis=-1, keepdims=True), sink)
    p = jnp.exp(s - m)
    denom = jnp.sum(p, axis=-1, keepdims=True) + jnp.exp(sink - m)
    return jnp.einsum('bnkgqs,bnskd->bnqkgd', p / denom, v.astype(F32))


def spatial_gate(u, v, w_s, b_s):
    tc = v.shape[2]
    causal = jnp.tril(jnp.ones((tc, tc), dtype=bool))
    ws = jnp.where(causal[None], w_s[:, :tc, :tc].astype(F32), 0.0)
    mixed = jnp.einsum('gij,bnjgc->bnigc', ws, v.astype(F32)) + b_s[:, :tc].astype(F32).T[:, :, None]
    return u.astype(F32) * mixed


def split_even(z):
    sizes = (A_WIDTH, A_KV_WIDTH, A_KV_WIDTH, A_WIDTH, B_WIDTH, B_WIDTH, B_WIDTH)
    idx = [int(i) for i in np.cumsum(sizes)[:-1]]
    return jnp.split(z, idx, axis=-1)


def even_output(x, a, ga, bo, gb, w_out):
    mixed = jnp.concatenate([jax.nn.silu(ga.astype(F32)) * a, jax.nn.silu(gb.astype(F32)) * bo], axis=-1)
    return x + mixed.astype(x.dtype) @ w_out


def shift_band(t):
    prev = jnp.concatenate([jnp.zeros_like(t[:, :1]), t[:, :-1]], axis=1)
    return jnp.concatenate([prev, t], axis=2)


def even_layer_prompt(x, g_mix, w_in, sinks, w_s, b_s, lnv_g, lnv_b, w_out):
    bsz, seq, _ = x.shape
    q, k, v, ga, u, vb, gb = split_even(rmsnorm(x, g_mix) @ w_in)
    nb = seq // WINDOW
    k = k.reshape(bsz, seq, A_KV_HEADS, A_HEAD_DIM)
    v = v.reshape(bsz, seq, A_KV_HEADS, A_HEAD_DIM)
    kb = shift_band(k.reshape(bsz, nb, WINDOW, A_KV_HEADS, A_HEAD_DIM))
    vbk = shift_band(v.reshape(bsz, nb, WINDOW, A_KV_HEADS, A_HEAD_DIM))
    pos = jnp.arange(seq, dtype=jnp.int32).reshape(nb, WINDOW)
    k_pos = jnp.concatenate([pos - WINDOW, pos], axis=1)
    qb = q.reshape(bsz, nb, WINDOW, A_KV_HEADS, A_GROUP, A_HEAD_DIM)
    a = sink_window_attention(qb, kb, vbk, pos, k_pos, sinks).reshape(bsz, seq, A_WIDTH)
    vn = standardize(vb) * lnv_g.astype(F32) + lnv_b.astype(F32)
    gshape = (bsz, seq // CHUNK, CHUNK, B_GROUPS, B_GROUP_DIM)
    bo = spatial_gate(u.reshape(gshape), vn.reshape(gshape), w_s, b_s).reshape(bsz, seq, B_WIDTH)
    return even_output(x, a, ga, bo, gb, w_out), k[:, -WINDOW:], v[:, -WINDOW:]


def even_layer_sample(x, win_k, win_v, g_mix, w_in, sinks, w_s, b_s, lnv_g, lnv_b, w_out):
    bsz, t, _ = x.shape
    q, k, v, ga, u, vb, gb = split_even(rmsnorm(x, g_mix) @ w_in)
    kk = jnp.concatenate([win_k.astype(x.dtype), k.reshape(bsz, t, A_KV_HEADS, A_HEAD_DIM)], axis=1)
    vv = jnp.concatenate([win_v.astype(x.dtype), v.reshape(bsz, t, A_KV_HEADS, A_HEAD_DIM)], axis=1)
    q_pos = (PAST_LEN + jnp.arange(t, dtype=jnp.int32))[None]
    k_pos = (PAST_LEN - WINDOW + jnp.arange(WINDOW + t, dtype=jnp.int32))[None]
    qb = q.reshape(bsz, 1, t, A_KV_HEADS, A_GROUP, A_HEAD_DIM)
    a = sink_window_attention(qb, kk[:, None], vv[:, None], q_pos, k_pos, sinks).reshape(bsz, t, A_WIDTH)
    vn = standardize(vb) * lnv_g.astype(F32) + lnv_b.astype(F32)
    gshape = (bsz, 1, t, B_GROUPS, B_GROUP_DIM)
    bo = spatial_gate(u.reshape(gshape), vn.reshape(gshape), w_s, b_s).reshape(bsz, t, B_WIDTH)
    y = even_output(x, a, ga, bo, gb, w_out)
    return y, kk[:, -WINDOW:], vv[:, -WINDOW:], vn.astype(x.dtype)


def retention_chunk(state, q, k, v, log_g):
    t = q.shape[1]
    i = jnp.arange(t, dtype=F32)
    rel = i[:, None] - i[None, :]
    decay = jnp.where(rel[None] >= 0, jnp.exp(jnp.maximum(rel, 0.0)[None] * log_g[:, None, None]), 0.0)
    scores = jnp.einsum('bthd,bshd->bhts', q, k) * decay[None]
    inner = jnp.einsum('bhts,bshe->bthe', scores, v)
    q_decay = jnp.exp((i[:, None] + 1.0) * log_g[None, :])
    cross = jnp.einsum('bthd,bhde->bthe', q * q_decay[None, :, :, None], state)
    k_decay = jnp.exp((t - 1.0 - i)[:, None] * log_g[None, :])
    new_state = jnp.exp(t * log_g)[None, :, None, None] * state + jnp.einsum('bshd,bshe->bhde', k * k_decay[None, :, :, None], v)
    return new_state, inner + cross


def split_ret(z, bsz, t):
    q, k, v, g = jnp.split(z, [R_K_WIDTH, 2 * R_K_WIDTH, 2 * R_K_WIDTH + R_V_WIDTH], axis=-1)
    q = q.reshape(bsz, t, R_HEADS, R_KEY_DIM).astype(F32)
    k = k.reshape(bsz, t, R_HEADS, R_KEY_DIM).astype(F32) * (R_KEY_DIM ** -0.5)
    v = v.reshape(bsz, t, R_HEADS, R_VAL_DIM).astype(F32)
    return q, k, v, g


def ret_output(x, o, g, w_out):
    bsz, t = x.shape[0], x.shape[1]
    on = standardize(o).reshape(bsz, t, R_V_WIDTH)
    return x + (jax.nn.silu(g.astype(F32)) * on).astype(x.dtype) @ w_out


def odd_layer_prompt(x, g_mix, w_in, w_out):
    bsz, seq, _ = x.shape
    q, k, v, g = split_ret(rmsnorm(x, g_mix) @ w_in, bsz, seq)
    log_g = retention_log_decay()
    nc = seq // R_CHUNK

    def to_chunks(a):
        return a.reshape(bsz, nc, R_CHUNK, a.shape[2], a.shape[3]).swapaxes(0, 1)

    def step(state, qkv):
        qc, kc, vc = qkv
        return retention_chunk(state, qc, kc, vc, log_g)

    state0 = jnp.zeros((bsz, R_HEADS, R_KEY_DIM, R_VAL_DIM), F32)
    state, o = lax.scan(step, state0, (to_chunks(q), to_chunks(k), to_chunks(v)))
    o = o.swapaxes(0, 1).reshape(bsz, seq, R_HEADS, R_VAL_DIM)
    return ret_output(x, o, g, w_out), state.astype(x.dtype)


def odd_layer_sample(x, state, g_mix, w_in, w_out):
    bsz, t, _ = x.shape
    q, k, v, g = split_ret(rmsnorm(x, g_mix) @ w_in, bsz, t)
    new_state, o = retention_chunk(state.astype(F32), q, k, v, retention_log_decay())
    return ret_output(x, o, g, w_out), new_state.astype(state.dtype)


def memory_kv(mem, g_mem, w_k, w_v):
    bsz, m, _ = mem.shape
    h = rmsnorm(mem, g_mem)
    return (h @ w_k).reshape(bsz, m, X_HEADS, X_HEAD_DIM), (h @ w_v).reshape(bsz, m, X_HEADS, X_HEAD_DIM)


def cross_attend(x, g, w_q, w_o, mem_k, mem_v):
    bsz, t, _ = x.shape
    q = (rmsnorm(x, g) @ w_q).reshape(bsz, t, X_HEADS, X_HEAD_DIM)
    s = jnp.einsum('bthd,bmhd->bhtm', q.astype(F32), mem_k.astype(F32)) * (X_HEAD_DIM ** -0.5)
    p = jax.nn.softmax(s, axis=-1)
    o = jnp.einsum('bhtm,bmhd->bthd', p, mem_v.astype(F32)).reshape(bsz, t, X_WIDTH)
    return x + o.astype(x.dtype) @ w_o


def setup_inputs(seed: int = 0) -> dict:
    key = jax.random.key(seed)
    ks = iter(jax.random.split(key, 32))

    def nrm(shape, scale):
        return scale * jax.random.normal(next(ks), shape, F32)

    na, nr = N_ATTN_LAYERS, N_RET_LAYERS
    return {
        'x_prompt': nrm((BATCH, SEQ, D_MODEL), 1.0),
        'x_sample': nrm((DEC_BATCH, DEC_SEQ, D_MODEL), 1.0),
        'cache_win_k': nrm((na, DEC_BATCH, WINDOW, A_KV_HEADS, A_HEAD_DIM), 1.0),
        'cache_win_v': nrm((na, DEC_BATCH, WINDOW, A_KV_HEADS, A_HEAD_DIM), 1.0),
        'state_ret': nrm((nr, DEC_BATCH, R_HEADS, R_KEY_DIM, R_VAL_DIM), 0.3),
        'cache_mem_k': nrm((DEPTH, DEC_BATCH, MEM_LEN, X_HEADS, X_HEAD_DIM), 1.0),
        'cache_mem_v': nrm((DEPTH, DEC_BATCH, MEM_LEN, X_HEADS, X_HEAD_DIM), 1.0),
        'mem_prompt': nrm((BATCH, MEM_LEN, D_MODEL), 1.0),
        'norm_mix': 1.0 + nrm((DEPTH, D_MODEL), 0.02),
        'w_in_even': nrm((na, D_MODEL, EVEN_IN), D_MODEL ** -0.5),
        'attn_sinks': nrm((na, A_HEADS), 1.0),
        'w_spatial': nrm((na, B_GROUPS, CHUNK, CHUNK), CHUNK ** -0.5),
        'b_spatial': 1.0 + nrm((na, B_GROUPS, CHUNK), 0.1),
        'norm_v_g': 1.0 + nrm((na, B_WIDTH), 0.02),
        'norm_v_b': nrm((na, B_WIDTH), 0.02),
        'w_out_even': nrm((na, EVEN_OUT, D_MODEL), EVEN_OUT ** -0.5),
        'w_in_ret': nrm((nr, D_MODEL, RET_IN), D_MODEL ** -0.5),
        'w_out_ret': nrm((nr, R_V_WIDTH, D_MODEL), R_V_WIDTH ** -0.5),
        'norm_cross': 1.0 + nrm((DEPTH, D_MODEL), 0.02),
        'norm_mem': 1.0 + nrm((DEPTH, D_MODEL), 0.02),
        'w_xq': nrm((DEPTH, D_MODEL, X_WIDTH), D_MODEL ** -0.5),
        'w_xk': nrm((DEPTH, D_MODEL, X_WIDTH), D_MODEL ** -0.5),
        'w_xv': nrm((DEPTH, D_MODEL, X_WIDTH), D_MODEL ** -0.5),
        'w_xo': nrm((DEPTH, X_WIDTH, D_MODEL), X_WIDTH ** -0.5),
        'norm_final': 1.0 + nrm((D_MODEL,), 0.02),
    }


def reference(x_prompt, x_sample, cache_win_k, cache_win_v, state_ret, cache_mem_k, cache_mem_v, mem_prompt,
              norm_mix, w_in_even, attn_sinks, w_spatial, b_spatial, norm_v_g, norm_v_b, w_out_even,
              w_in_ret, w_out_ret, norm_cross, norm_mem, w_xq, w_xk, w_xv, w_xo, norm_final):
    xp, xs = x_prompt, x_sample
    wkp, wvp, rsp, mkp, mvp = [], [], [], [], []
    wks, wvs, rss, cvs = [], [], [], []
    for layer in range(DEPTH):
        i = layer // 2
        if layer % 2 == 0:
            params = (norm_mix[layer], w_in_even[i], attn_sinks[i], w_spatial[i], b_spatial[i],
                      norm_v_g[i], norm_v_b[i], w_out_even[i])
            xp, kp, vp = even_layer_prompt(xp, *params)
            xs, ksn, vsn, cv = even_layer_sample(xs, cache_win_k[i], cache_win_v[i], *params)
            wkp.append(kp)
            wvp.append(vp)
            wks.append(ksn)
            wvs.append(vsn)
            cvs.append(cv)
        else:
            xp, sp = odd_layer_prompt(xp, norm_mix[layer], w_in_ret[i], w_out_ret[i])
            xs, ss = odd_layer_sample(xs, state_ret[i], norm_mix[layer], w_in_ret[i], w_out_ret[i])
            rsp.append(sp)
            rss.append(ss)
        mk, mv = memory_kv(mem_prompt, norm_mem[layer], w_xk[layer], w_xv[layer])
        mkp.append(mk)
        mvp.append(mv)
        xp = cross_attend(xp, norm_cross[layer], w_xq[layer], w_xo[layer], mk, mv)
        xs = cross_attend(xs, norm_cross[layer], w_xq[layer], w_xo[layer], cache_mem_k[layer], cache_mem_v[layer])
    y_prompt = rmsnorm(xp, norm_final)
    y_sample = rmsnorm(xs, norm_final)
    return (y_prompt, y_sample,
            jnp.stack(wkp), jnp.stack(wvp), jnp.stack(rsp), jnp.stack(mkp), jnp.stack(mvp),
            jnp.stack(wks), jnp.stack(wvs), jnp.stack(rss), jnp.stack(cvs))
```

```cpp
#include <hip/hip_runtime.h>
#include <hip/hip_cooperative_groups.h>
#include <cstdio>
#include <cstdint>
namespace cg = cooperative_groups;
namespace pg8 {
#define PG8_LAS __attribute__((address_space(3)))
typedef unsigned short bf16_t;
typedef short bf16x8 __attribute__((ext_vector_type(8)));
typedef float f32x4 __attribute__((ext_vector_type(4)));
typedef unsigned u32x4 __attribute__((ext_vector_type(4)));
constexpr int BM = 256, BK = 64, HALF = 128, HTB = HALF * BK * 2  , STAGE_BYTES = 8 * HTB, NXCD = 8, WGM = 8;

__host__ __device__ __forceinline__ int lds_byte(int r, int c) { const int st = (r >> 4) * 2 + (c >> 5), rr = r & 15, cc = c & 31, ob = rr * 64 + cc * 2; return st * 1024 + (ob ^ (((ob >> 9) & 1) << 5)); }
__host__ __device__ __forceinline__ void stage_rc(int b, int& R, int& C) { const int st = b / 1024, sb = b % 1024, swz = sb ^ (((sb >> 9) & 1) << 5); R = (st >> 1) * 16 + swz / 64; C = (st & 1) * 32 + (swz % 64) / 2; }
__host__ __device__ __forceinline__ int perm32(int rho) { const int n = rho >> 4, i = rho & 15; return 8 * (i >> 2) + 4 * n + (i & 3); }

struct Unit { int pm, pn; };
struct Gemm { const bf16_t* A; const bf16_t* Bt; int M, N, K, ld; };

struct StaticOrder {
    int nM, nN, nwg, G, c;
    __host__ __device__ void init(int M, int N, int G_, int c_) { nM = M / BM; nN = N / BM; nwg = nM * nN; G = G_; c = c_; }
    __host__ __device__ bool next(int i, Unit& u) const {
        const long L = (long)i * G + c; if (L >= nwg) return false;
        int wgid = (int)L; { const int q = nwg / NXCD, r = nwg % NXCD, xcd = wgid % NXCD, off = wgid / NXCD; wgid = (xcd < r ? xcd * (q + 1) : r * (q + 1) + (xcd - r) * q) + off; }
        const int nig = WGM * nN, gid = wgid / nig, fm = gid * WGM, gsz = (nM - fm) < WGM ? (nM - fm) : WGM;
        u.pm = fm + ((wgid % nig) % gsz); u.pn = (wgid % nig) / gsz; return true;
    }
    __device__ __forceinline__ void a_ready(const Unit&) const {}
    __device__ __forceinline__ void done(const Unit&) const {}
};
typedef float f32x2c __attribute__((ext_vector_type(2)));
typedef __bf16 bf16x2c __attribute__((ext_vector_type(2)));
__device__ __forceinline__ unsigned cvt_pk_bf16(float lo, float hi) { const f32x2c f = {lo, hi}; const bf16x2c h = __builtin_convertvector(f, bf16x2c); return __builtin_bit_cast(unsigned, h); }
template <class Epi, class Sched, bool ALIGN_EPI = false, bool SP2 = false>
__device__ __forceinline__ void gemm_phase(PG8_LAS unsigned char* lds, const Gemm g, const Sched& S, const Epi& E) {
    int tid_o = threadIdx.x; asm volatile("" : "+v"(tid_o));
    const int tid = tid_o, wid = __builtin_amdgcn_readfirstlane(tid >> 6), lane = tid & 63, wr = wid >> 2, wc = wid & 3, fr = lane & 15, fq = lane >> 4;
    const int K = g.ld, nt = g.K / BK;
    unsigned voffA[2], voffB[2];
#pragma unroll
    for (int i = 0; i < 2; ++i) { int R, C; stage_rc(tid * 16 + i * 8192, R, C); const int Rb = Epi::PERM ? ((R & ~31) + perm32(R & 31)) : R;
        voffA[i] = (unsigned)(R * K + C) * 2u; voffB[i] = (unsigned)(Rb * K + C) * 2u; }
    const size_t kstep = (size_t)(BK * 2);
    const size_t hstep = (size_t)HALF * K * 2;
    const size_t tstep = 2 * hstep;
    const unsigned ldsw = (unsigned)wid * 1024u;
    const int aoff = lds_byte(wr * 64 + fr, fq * 8), boff = lds_byte(wc * 32 + fr, fq * 8);
#define PG8_SA(b, h) (((b) * 2 + (h)) * HTB)
#define PG8_SB(b, h) ((4 + (b) * 2 + (h)) * HTB)
#define PG8_STAGE(bufoff, gbase, voff) do { _Pragma("unroll") for (int _i = 0; _i < 2; ++_i) \
        __builtin_amdgcn_global_load_lds((const unsigned*)((const char*)(gbase) + (voff)[_i]), (PG8_LAS unsigned*)(lds + (bufoff) + ldsw + _i * 8192), 16, 0, 0); } while (0)
#define PG8_LDA(dst, b, h) do { _Pragma("unroll") for (int m = 0; m < 4; ++m) _Pragma("unroll") for (int k = 0; k < 2; ++k) dst[m][k] = *(const PG8_LAS bf16x8*)(lds + PG8_SA(b, h) + aoff + m * 2048 + k * 1024); } while (0)
#define PG8_LDB(dst, b, h) do { _Pragma("unroll") for (int n = 0; n < 2; ++n) _Pragma("unroll") for (int k = 0; k < 2; ++k) dst[n][k] = *(const PG8_LAS bf16x8*)(lds + PG8_SB(b, h) + boff + n * 2048 + k * 1024); } while (0)
#define PG8_MMA(ai, bj, At, Bt) do { __builtin_amdgcn_s_setprio(1); _Pragma("unroll") for (int m = 0; m < 4; ++m) _Pragma("unroll") for (int n = 0; n < 2; ++n) _Pragma("unroll") for (int k = 0; k < 2; ++k) \
        acc[ai][bj][m][n] = __builtin_amdgcn_mfma_f32_16x16x32_bf16(Bt[n][k], At[m][k], acc[ai][bj][m][n], 0, 0, 0); __builtin_amdgcn_s_setprio(0); } while (0)
#define PG8_WAIT_V(n) asm volatile("s_waitcnt vmcnt(" #n ")" ::: "memory")
#define PG8_WAIT_L(n) asm volatile("s_waitcnt lgkmcnt(" #n ")" ::: "memory")
#define PG8_BAR __builtin_amdgcn_s_barrier()
#define PG8_SCHED __builtin_amdgcn_sched_barrier(0)
    Unit cur, nxt; int ui = 0;
    if (!S.next(0, cur)) return;
    f32x4 acc[2][2][4][2];
#pragma unroll
    for (int a = 0; a < 2; ++a)
#pragma unroll
        for (int b = 0; b < 2; ++b)
#pragma unroll
            for (int m = 0; m < 4; ++m)
#pragma unroll
                for (int n = 0; n < 2; ++n) acc[a][b][m][n] = (f32x4){0.f, 0.f, 0.f, 0.f};
    bf16x8 At[4][2], B0[2][2], B1[2][2];
    const char* cA = (const char*)g.A + (size_t)cur.pm * tstep; const char* cB = (const char*)g.Bt + (size_t)cur.pn * tstep;
    S.a_ready(cur);
    if constexpr (SP2) {
        PG8_STAGE(PG8_SB(0, 0), cB, voffB); PG8_STAGE(PG8_SB(0, 1), cB + hstep, voffB); PG8_STAGE(PG8_SA(0, 0), cA, voffA); PG8_STAGE(PG8_SA(0, 1), cA + hstep, voffA);
        if (wr == 1) PG8_BAR;
        PG8_WAIT_V(2); PG8_BAR;
        PG8_STAGE(PG8_SB(1, 0), cB + kstep, voffB); PG8_STAGE(PG8_SA(1, 0), cA + kstep, voffA); PG8_STAGE(PG8_SB(1, 1), cB + hstep + kstep, voffB);
        PG8_WAIT_V(6); PG8_BAR;
    } else {
        PG8_STAGE(PG8_SB(0, 0), cB, voffB); PG8_STAGE(PG8_SA(0, 0), cA, voffA); PG8_STAGE(PG8_SB(0, 1), cB + hstep, voffB); PG8_STAGE(PG8_SA(0, 1), cA + hstep, voffA);
        if (wr == 1) PG8_BAR;
        PG8_WAIT_V(4); PG8_BAR;
        PG8_STAGE(PG8_SB(1, 0), cB + kstep, voffB); PG8_STAGE(PG8_SA(1, 0), cA + kstep, voffA); PG8_STAGE(PG8_SB(1, 1), cB + hstep + kstep, voffB);
        PG8_WAIT_V(6); PG8_BAR;
    }
    for (;;) {
        const bool has_next = S.next(ui + 1, nxt);
        const char* nA = has_next ? (const char*)g.A + (size_t)nxt.pm * tstep : cA; const char* nB = has_next ? (const char*)g.Bt + (size_t)nxt.pn * tstep : cB;
        for (int t = 0; t < nt; t += 2) {
            const bool last = (t == nt - 2);
            const char* a1 = cA + (size_t)(t + 1) * kstep;
            const char* a2 = last ? nA : cA + (size_t)(t + 2) * kstep; const char* b2 = last ? nB : cB + (size_t)(t + 2) * kstep;
            const char* a3 = a2 + kstep; const char* b3 = b2 + kstep;
            if (last && has_next) S.a_ready(nxt);
            if constexpr (SP2) {
            PG8_LDB(B0, 0, 0); PG8_LDB(B1, 0, 1); PG8_SCHED; PG8_LDA(At, 0, 0); PG8_STAGE(PG8_SA(1, 1), a1 + hstep, voffA);
            PG8_WAIT_V(8); PG8_WAIT_L(0); PG8_BAR; PG8_MMA(0, 0, At, B0); PG8_MMA(0, 1, At, B1); PG8_BAR; PG8_SCHED;
            PG8_LDA(At, 0, 1); PG8_STAGE(PG8_SB(0, 0), b2, voffB); PG8_STAGE(PG8_SB(0, 1), b2 + hstep, voffB); PG8_STAGE(PG8_SA(0, 0), a2, voffA);
            PG8_WAIT_V(8); PG8_WAIT_L(0); PG8_BAR; PG8_MMA(1, 0, At, B0); PG8_MMA(1, 1, At, B1); PG8_BAR; PG8_SCHED;
            PG8_LDB(B0, 1, 0); PG8_LDB(B1, 1, 1); PG8_SCHED; PG8_LDA(At, 1, 0); PG8_STAGE(PG8_SA(0, 1), a2 + hstep, voffA);
            PG8_WAIT_V(8); PG8_WAIT_L(0); PG8_BAR; PG8_MMA(0, 0, At, B0); PG8_MMA(0, 1, At, B1); PG8_BAR; PG8_SCHED;
            PG8_LDA(At, 1, 1); PG8_STAGE(PG8_SB(1, 0), b3, voffB); PG8_STAGE(PG8_SB(1, 1), b3 + hstep, voffB); PG8_STAGE(PG8_SA(1, 0), a3, voffA);
            PG8_WAIT_V(8); PG8_WAIT_L(0); PG8_BAR; PG8_MMA(1, 0, At, B0); PG8_MMA(1, 1, At, B1); PG8_BAR; PG8_SCHED;
            } else {
            PG8_LDB(B0, 0, 0); PG8_SCHED; PG8_LDA(At, 0, 0); PG8_STAGE(PG8_SA(1, 1), a1 + hstep, voffA);
            PG8_WAIT_L(8); PG8_BAR; PG8_WAIT_L(0); PG8_MMA(0, 0, At, B0); PG8_BAR; PG8_SCHED;
            PG8_LDB(B1, 0, 1); PG8_STAGE(PG8_SB(0, 0), b2, voffB);
            PG8_BAR; PG8_WAIT_L(0); PG8_MMA(0, 1, At, B1); PG8_BAR;
            PG8_LDA(At, 0, 1); PG8_STAGE(PG8_SA(0, 0), a2, voffA);
            PG8_BAR; PG8_WAIT_L(0); PG8_MMA(1, 0, At, B0); PG8_BAR; PG8_SCHED;
            PG8_STAGE(PG8_SB(0, 1), b2 + hstep, voffB);
            PG8_WAIT_V(6); PG8_BAR; PG8_MMA(1, 1, At, B1); PG8_BAR;
            PG8_LDB(B0, 1, 0); PG8_SCHED; PG8_LDA(At, 1, 0); PG8_STAGE(PG8_SA(0, 1), a2 + hstep, voffA);
            PG8_WAIT_L(8); PG8_BAR; PG8_WAIT_L(0); PG8_MMA(0, 0, At, B0); PG8_BAR; PG8_SCHED;
            PG8_LDB(B1, 1, 1); PG8_STAGE(PG8_SB(1, 0), b3, voffB);
            PG8_BAR; PG8_WAIT_L(0); PG8_MMA(0, 1, At, B1); PG8_BAR;
            PG8_LDA(At, 1, 1); PG8_STAGE(PG8_SA(1, 0), a3, voffA);
            PG8_BAR; PG8_WAIT_L(0); PG8_MMA(1, 0, At, B0); PG8_BAR; PG8_SCHED;
            PG8_STAGE(PG8_SB(1, 1), b3 + hstep, voffB);
            PG8_WAIT_V(6); PG8_BAR; PG8_MMA(1, 1, At, B1); PG8_BAR;
            }
        }
        if constexpr (ALIGN_EPI) { if (wr == 0) PG8_BAR; }
        if constexpr (!Epi::AFTER_DRAIN) { E(acc, cur, wr, wc, fr, fq); S.done(cur); }
        if (!has_next) break;
#pragma unroll
        for (int a = 0; a < 2; ++a)
#pragma unroll
            for (int b = 0; b < 2; ++b)
#pragma unroll
                for (int m = 0; m < 4; ++m)
#pragma unroll
                    for (int n = 0; n < 2; ++n) acc[a][b][m][n] = (f32x4){0.f, 0.f, 0.f, 0.f};
        cur = nxt; cA = nA; cB = nB; ++ui;
        if constexpr (ALIGN_EPI) { if (wr == 1) PG8_BAR; }
    }
    PG8_WAIT_V(0);
    if constexpr (!ALIGN_EPI) { if (wr == 0) PG8_BAR; }
    PG8_BAR;
    if constexpr (Epi::AFTER_DRAIN) { E.fused(acc, cur, wr, wc, fr, fq, lds, wid, lane); S.done(cur); }
#undef PG8_SA
#undef PG8_SB
#undef PG8_STAGE
#undef PG8_LDA
#undef PG8_LDB
#undef PG8_MMA
#undef PG8_WAIT_V
#undef PG8_WAIT_L
#undef PG8_BAR
#undef PG8_SCHED
}
}

#define LAS __attribute__((address_space(3)))
typedef unsigned short bf16_t;
typedef short bf16x8 __attribute__((ext_vector_type(8)));
typedef short s16x4 __attribute__((ext_vector_type(4)));
typedef float f32x4 __attribute__((ext_vector_type(4)));
typedef float f32x2 __attribute__((ext_vector_type(2)));
typedef unsigned u32x4 __attribute__((ext_vector_type(4)));
typedef unsigned u32x2 __attribute__((ext_vector_type(2)));

constexpr int T_P = 8192, T_ALL = 8448, SEQL = 4096;
constexpr int EIN = 5376, RIN = 12288;
constexpr float EPSN = 1e-6f;
constexpr size_t WS_WINE = 0;
constexpr size_t WS_WOUTE = WS_WINE + 2ull * EIN * 2048 * 2;
constexpr size_t WS_WINR = WS_WOUTE + 2ull * 2048 * 2048 * 2;
constexpr size_t WS_WOUTR = WS_WINR + 2ull * RIN * 2048 * 2;
constexpr size_t WS_WXQ = WS_WOUTR + 2ull * 2048 * 4096 * 2;
constexpr size_t WS_WXO = WS_WXQ + 4ull * 512 * 2048 * 2;
constexpr size_t WS_WXKV = WS_WXO + 4ull * 2048 * 512 * 2;
constexpr size_t WS_X = WS_WXKV + 4096ull * 2048 * 2;
constexpr size_t WS_XB = WS_X + (size_t)T_ALL * 2048 * 4;
constexpr size_t WS_SS = WS_XB + (size_t)T_ALL * 2048 * 2;
constexpr size_t WS_Z = WS_SS + (size_t)T_ALL * 32 * 4;
constexpr size_t WS_MIX = WS_Z + (size_t)T_ALL * RIN * 2;
constexpr size_t WS_O = WS_MIX + (size_t)T_ALL * 4096 * 2;
constexpr size_t WS_VT = WS_O + (size_t)T_ALL * 4096 * 2;
constexpr size_t WS_MEMB = WS_VT + 128ull * T_ALL * 2;
constexpr size_t WS_MEMSS = WS_MEMB + 512ull * 2048 * 2;
constexpr size_t WS_MEMKV = WS_MEMSS + 512ull * 32 * 4;
constexpr size_t WS_MEMVT = WS_MEMKV + 512ull * 4096 * 2;
constexpr size_t WS_XQ = WS_MEMVT + 4ull * 2 * 512 * 256 * 2;
constexpr size_t WS_XO = WS_XQ + (size_t)T_ALL * 512 * 2;
constexpr size_t WS_BAR = WS_XO + (size_t)T_ALL * 512 * 2;
constexpr size_t WS_END = WS_BAR + 16384;

constexpr size_t OUT_YP = 0, OUT_WKP = 17301504, OUT_WVP = 17367040, OUT_RSP = 17432576, OUT_MKP = 21626880, OUT_MVP = 22675456,
                 OUT_WKS = 23724032, OUT_WVS = 24772608, OUT_RSS = 25821184, OUT_CVS = 92930048, OUT_TOTAL = 93454336;

constexpr int LDS_BYTES = 147456;
constexpr int NTHREADS = 512;

struct Params { const float* in[25]; float* out; unsigned char* ws; int ph_lo, ph_hi; };

#define MFMA16(a, b, c) __builtin_amdgcn_mfma_f32_16x16x32_bf16((a), (b), (c), 0, 0, 0)

__device__ __forceinline__ float bf_lo(unsigned w) { return __uint_as_float(w << 16); }
__device__ __forceinline__ float bf_hi(unsigned w) { return __uint_as_float(w & 0xffff0000u); }
__device__ __forceinline__ float bf1(bf16_t h) { return __uint_as_float((unsigned)h << 16); }
__device__ __forceinline__ unsigned pk2(float lo, float hi) { return pg8::cvt_pk_bf16(lo, hi); }
__device__ __forceinline__ bf16_t f2bf(float f) { return (bf16_t)(pk2(f, 0.f) & 0xffffu); }
__device__ __forceinline__ float silu_f(float x) { return x * __builtin_amdgcn_rcpf(1.0f + __expf(-x)); }
__device__ __forceinline__ float wave_sum(float v) {
#pragma unroll
    for (int o = 1; o < 64; o <<= 1) v += __shfl_xor(v, o);
    return v;
}
__device__ __forceinline__ float wave_max(float v) {
#pragma unroll
    for (int o = 1; o < 64; o <<= 1) v = fmaxf(v, __shfl_xor(v, o));
    return v;
}
__device__ __forceinline__ bf16x8 as_bf16x8(u32x4 w) { return __builtin_bit_cast(bf16x8, w); }
__device__ __forceinline__ bf16x8 tr_read8(LAS unsigned char* p0, LAS unsigned char* p1) {
    const s16x4 a = __builtin_amdgcn_ds_read_tr16_b64_v4i16((LAS s16x4*)p0);
    const s16x4 b = __builtin_amdgcn_ds_read_tr16_b64_v4i16((LAS s16x4*)p1);
    return (bf16x8){a[0], a[1], a[2], a[3], b[0], b[1], b[2], b[3]};
}

namespace pg8 {
__device__ __forceinline__ void row_rstd(const float* sspart, int rowbase, int wr, int fr, int fq, float (&rs)[2][4]) {
#pragma unroll
    for (int ai = 0; ai < 2; ++ai)
#pragma unroll
        for (int m = 0; m < 4; ++m) {
            const int row = rowbase + ai * HALF + wr * 64 + m * 16 + fr;
            const f32x4* sp = (const f32x4*)(sspart + (size_t)row * 32 + 8 * fq);
            const f32x4 a = sp[0], b = sp[1];
            float s = (a[0] + a[1]) + (a[2] + a[3]) + (b[0] + b[1]) + (b[2] + b[3]);
            s += __shfl_xor(s, 16); s += __shfl_xor(s, 32);
            rs[ai][m] = rsqrtf(s * (1.0f / 2048.0f) + 1e-6f);
        }
}
struct EpiZ {
    static constexpr bool PERM = true, AFTER_DRAIN = false;
    bf16_t* O; int ldc; const float* sspart; int s1lo, s1hi, s2lo, s2hi; int vt_pn; bf16_t* vt; int vt_ld;
    __device__ __forceinline__ void operator()(const f32x4 (&acc)[2][2][4][2], const Unit& u, int wr, int wc, int fr, int fq) const {
        float rs[2][4]; row_rstd(sspart, u.pm * BM, wr, fr, fq, rs);
        const bool act = (u.pn >= s1lo && u.pn < s1hi) || (u.pn >= s2lo && u.pn < s2hi);
        const int row0 = u.pm * BM + wr * 64 + fr, col0 = u.pn * BM + wc * 32 + 8 * fq;
#pragma unroll
        for (int ai = 0; ai < 2; ++ai)
#pragma unroll
            for (int m = 0; m < 4; ++m) {
                const int row = row0 + ai * HALF + m * 16; bf16_t* rowp = O + (size_t)row * ldc + col0; const float r = rs[ai][m];
#pragma unroll
                for (int bj = 0; bj < 2; ++bj) {
                    f32x4 v0 = acc[ai][bj][m][0] * r, v1 = acc[ai][bj][m][1] * r;
                    if (act) {
#pragma unroll
                        for (int e = 0; e < 4; ++e) { v0[e] = ::silu_f(v0[e]); v1[e] = ::silu_f(v1[e]); }
                    }
                    u32x4 w; w.x = cvt_pk_bf16(v0[0], v0[1]); w.y = cvt_pk_bf16(v0[2], v0[3]); w.z = cvt_pk_bf16(v1[0], v1[1]); w.w = cvt_pk_bf16(v1[2], v1[3]);
                    *(u32x4*)(rowp + bj * HALF) = w;
                    if (bj == 1 && u.pn == vt_pn) {
                        bf16_t* vp = vt + (size_t)(wc * 32 + 8 * fq) * vt_ld + row;
                        vp[0] = (bf16_t)(w.x & 0xffffu); vp[(size_t)vt_ld] = (bf16_t)(w.x >> 16);
                        vp[(size_t)2 * vt_ld] = (bf16_t)(w.y & 0xffffu); vp[(size_t)3 * vt_ld] = (bf16_t)(w.y >> 16);
                        vp[(size_t)4 * vt_ld] = (bf16_t)(w.z & 0xffffu); vp[(size_t)5 * vt_ld] = (bf16_t)(w.z >> 16);
                        vp[(size_t)6 * vt_ld] = (bf16_t)(w.w & 0xffffu); vp[(size_t)7 * vt_ld] = (bf16_t)(w.w >> 16);
                    }
                }
            }
    }
};
struct EpiMem {
    static constexpr bool PERM = true, AFTER_DRAIN = false;
    bf16_t* kv; bf16_t* vtr; float* outk; float* outv; const float* sspart;
    __device__ __forceinline__ void operator()(const f32x4 (&acc)[2][2][4][2], const Unit& u, int wr, int wc, int fr, int fq) const {
        float rs[2][4]; row_rstd(sspart, u.pm * BM, wr, fr, fq, rs);
        const int row0 = u.pm * BM + wr * 64 + fr, col0 = u.pn * BM + wc * 32 + 8 * fq;
#pragma unroll
        for (int ai = 0; ai < 2; ++ai)
#pragma unroll
            for (int m = 0; m < 4; ++m) {
                const int row = row0 + ai * HALF + m * 16; const float r = rs[ai][m]; const int b = row >> 8, mm = row & 255;
#pragma unroll
                for (int bj = 0; bj < 2; ++bj) {
                    const int c = col0 + bj * HALF, l = c >> 10, wcol = c & 1023;
                    const f32x4 v0 = acc[ai][bj][m][0] * r, v1 = acc[ai][bj][m][1] * r;
                    u32x4 w; w.x = cvt_pk_bf16(v0[0], v0[1]); w.y = cvt_pk_bf16(v0[2], v0[3]); w.z = cvt_pk_bf16(v1[0], v1[1]); w.w = cvt_pk_bf16(v1[2], v1[3]);
                    *(u32x4*)(kv + (size_t)row * 4096 + c) = w;
                    float* op = (wcol < 512 ? outk : outv) + ((size_t)(l * 512 + row)) * 512 + (wcol & 511);
                    *(f32x4*)op = v0; *(f32x4*)(op + 4) = v1;
                    if (wcol >= 512) {
                        bf16_t* vp = vtr + ((size_t)((l * 2 + b) * 512 + (wcol - 512))) * 256 + mm;
                        vp[0] = (bf16_t)(w.x & 0xffffu); vp[256] = (bf16_t)(w.x >> 16); vp[512] = (bf16_t)(w.y & 0xffffu); vp[768] = (bf16_t)(w.y >> 16);
                        vp[1024] = (bf16_t)(w.z & 0xffffu); vp[1280] = (bf16_t)(w.z >> 16); vp[1536] = (bf16_t)(w.w & 0xffffu); vp[1792] = (bf16_t)(w.w >> 16);
                    }
                }
            }
    }
};
struct EpiRes {
    static constexpr bool PERM = false, AFTER_DRAIN = false;
    bf16_t* xb; float* sspart;
    __device__ __forceinline__ void operator()(const f32x4 (&acc)[2][2][4][2], const Unit& u, int wr, int wc, int fr, int fq) const {
        const int row0 = u.pm * BM + wr * 64 + fr, col0 = u.pn * BM + wc * 32 + 4 * fq;
#pragma unroll
        for (int half_ = 0; half_ < 2; ++half_) {
            u32x2 old[4][4];
#pragma unroll
            for (int g4 = 0; g4 < 4; ++g4) {
                const size_t off = (size_t)(row0 + half_ * HALF + g4 * 16) * 2048 + col0;
#pragma unroll
                for (int q = 0; q < 4; ++q) old[g4][q] = *(const u32x2*)(xb + off + (q >> 1) * HALF + (q & 1) * 16);
            }
#pragma unroll
            for (int g4 = 0; g4 < 4; ++g4) {
                const int ai = half_, m = g4;
                const int row = row0 + ai * HALF + m * 16; const size_t off = (size_t)row * 2048 + col0; float ss = 0.f;
#pragma unroll
                for (int q = 0; q < 4; ++q) {
                    const int bj = q >> 1, n = q & 1;
                    const f32x4 a = acc[ai][bj][m][n]; const u32x2 o = old[g4][q];
                    u32x2 w; w.x = cvt_pk_bf16(__uint_as_float(o.x << 16) + a[0], __uint_as_float(o.x & 0xffff0000u) + a[1]);
                    w.y = cvt_pk_bf16(__uint_as_float(o.y << 16) + a[2], __uint_as_float(o.y & 0xffff0000u) + a[3]);
                    *(u32x2*)(xb + off + bj * HALF + n * 16) = w;
                    const float r0 = __uint_as_float(w.x << 16), r1 = __uint_as_float(w.x & 0xffff0000u), r2 = __uint_as_float(w.y << 16), r3 = __uint_as_float(w.y & 0xffff0000u);
                    ss += (r0 * r0 + r1 * r1) + (r2 * r2 + r3 * r3);
                }
                ss += __shfl_xor(ss, 16); ss += __shfl_xor(ss, 32);
                if (fq == 0) sspart[(size_t)row * 32 + u.pn * 4 + wc] = ss;
            }
        }
    }
};
}

namespace pg8 {
struct OneRound {
    StaticOrder S; int rnd;
    __device__ bool next(int i, Unit& u) const { return i == 0 && S.next(rnd, u); }
    __device__ __forceinline__ void a_ready(const Unit&) const {}
    __device__ __forceinline__ void done(const Unit&) const {}
};
}
__device__ __forceinline__ void p0_transpose_item(const float* W, int K, int N, bf16_t* WT, int row_off, LAS float* scr, int item, int lane,
                                                  const float* gain, int sc_lo, int sc_hi, float sc) {
    const int nblk = N / 32, kb = item / nblk, nb = item % nblk, k0 = 64 * kb, n0 = 32 * nb;
    f32x4 wv[8];
#pragma unroll
    for (int i = 0; i < 8; ++i) wv[i] = *(const f32x4*)(W + (size_t)(k0 + (lane >> 3) + 8 * i) * N + n0 + 4 * (lane & 7));
#pragma unroll
    for (int i = 0; i < 8; ++i) {
        const int kk = (lane >> 3) + 8 * i;
        const float gm = gain ? gain[k0 + kk] : 1.0f;
        LAS float* sp = scr + kk * 33 + 4 * (lane & 7);
        sp[0] = wv[i][0] * gm; sp[1] = wv[i][1] * gm; sp[2] = wv[i][2] * gm; sp[3] = wv[i][3] * gm;
    }
    asm volatile("s_waitcnt lgkmcnt(0)" ::: "memory");
    const int c = lane & 7;
#pragma unroll
    for (int j = 0; j < 4; ++j) {
        const int n = (lane >> 3) + 8 * j; const LAS float* s = scr + (8 * c) * 33 + n;
        const float mlt = (n0 + n >= sc_lo && n0 + n < sc_hi) ? sc : 1.0f;
        u32x4 o; o.x = pk2(s[0 * 33] * mlt, s[1 * 33] * mlt); o.y = pk2(s[2 * 33] * mlt, s[3 * 33] * mlt);
        o.z = pk2(s[4 * 33] * mlt, s[5 * 33] * mlt); o.w = pk2(s[6 * 33] * mlt, s[7 * 33] * mlt);
        *(u32x4*)(WT + (size_t)(row_off + n0 + n) * K + k0 + 8 * c) = o;
    }
    asm volatile("s_waitcnt lgkmcnt(0)" ::: "memory");
}
__device__ __forceinline__ void p0_row(const float* src, float* x32, bf16_t* xb, float* ssp, int lane) {
    const f32x4* xr = (const f32x4*)src + lane;
    f32x4 v[8]; float s = 0.f;
#pragma unroll
    for (int j = 0; j < 8; ++j) { v[j] = xr[64 * j]; s += (v[j][0] * v[j][0] + v[j][1] * v[j][1]) + (v[j][2] * v[j][2] + v[j][3] * v[j][3]); }
    s = wave_sum(s);
#pragma unroll
    for (int j = 0; j < 8; ++j) {
        if (x32) ((f32x4*)x32)[lane + 64 * j] = v[j];
        u32x2 w; w.x = pk2(v[j][0], v[j][1]); w.y = pk2(v[j][2], v[j][3]);
        ((u32x2*)xb)[lane + 64 * j] = w;
    }
    if (lane < 32) ssp[lane] = (lane == 0) ? s : 0.f;
}

__device__ __forceinline__ void attn_prompt_item(const bf16_t* z, const bf16_t* vt, bf16_t* mix, const float* sinks, int it, int lane) {
    const int h = it & 15, qt = it >> 4, b = qt >> 8, s0 = (qt & 255) << 4, kv = h >> 3;
    const int l15 = lane & 15, g = lane >> 4;
    const size_t tokq = (size_t)b * SEQL + s0 + l15;
    const bf16_t* qp = z + tokq * EIN + h * 64 + 8 * g;
    const bf16x8 qf0 = *(const bf16x8*)qp, qf1 = *(const bf16x8*)(qp + 32);
    const float slope = exp2f(-0.5f * (float)(h + 1));
    const float sink = sinks[h];
    f32x4 sc[9];
    float mx = -1e30f;
#pragma unroll
    for (int kt = 0; kt < 9; ++kt) {
        const int p0 = s0 - 128 + 16 * kt;
        const int key = p0 + l15, keyc = key < 0 ? 0 : key;
        const bf16_t* kp = z + ((size_t)b * SEQL + keyc) * EIN + 1024 + kv * 64 + 8 * g;
        const bf16x8 k0 = *(const bf16x8*)kp, k1 = *(const bf16x8*)(kp + 32);
        f32x4 a = {0.f, 0.f, 0.f, 0.f};
        a = MFMA16(k0, qf0, a); a = MFMA16(k1, qf1, a);
#pragma unroll
        for (int j = 0; j < 4; ++j) {
            const int kpos = p0 + 4 * g + j, dist = s0 + l15 - kpos;
            const bool valid = (dist >= 0) && (dist < 128) && (kpos >= 0);
            const float v = valid ? a[j] * 0.125f - slope * (float)dist : -1e30f;
            sc[kt][j] = v; mx = fmaxf(mx, v);
        }
    }
    s16x4 vq[5][4][2];
#pragma unroll
    for (int u = 0; u < 5; ++u) {
        int pos0 = s0 - 128 + 32 * u + 4 * g, pos1 = pos0 + 16;
        pos0 = pos0 < 0 ? 0 : pos0; pos1 = pos1 < 0 ? 0 : pos1;
#pragma unroll
        for (int mi = 0; mi < 4; ++mi) {
            const bf16_t* vp = vt + (size_t)(kv * 64 + mi * 16 + l15) * T_ALL + (size_t)b * SEQL;
            vq[u][mi][0] = *(const s16x4*)(vp + pos0); vq[u][mi][1] = *(const s16x4*)(vp + pos1);
        }
    }
    mx = fmaxf(mx, __shfl_xor(mx, 16)); mx = fmaxf(mx, __shfl_xor(mx, 32)); mx = fmaxf(mx, sink);
    float sum = 0.f;
#pragma unroll
    for (int kt = 0; kt < 9; ++kt)
#pragma unroll
        for (int j = 0; j < 4; ++j) { const float p = __expf(sc[kt][j] - mx); sc[kt][j] = p; sum += p; }
    sum += __shfl_xor(sum, 16); sum += __shfl_xor(sum, 32);
    const float inv = 1.0f / (sum + __expf(sink - mx));
    f32x4 o[4];
#pragma unroll
    for (int mi = 0; mi < 4; ++mi) o[mi] = (f32x4){0.f, 0.f, 0.f, 0.f};
#pragma unroll
    for (int u = 0; u < 5; ++u) {
        u32x4 pw; pw.x = pk2(sc[2 * u][0] * inv, sc[2 * u][1] * inv); pw.y = pk2(sc[2 * u][2] * inv, sc[2 * u][3] * inv);
        if (2 * u + 1 < 9) { pw.z = pk2(sc[(2 * u + 1) % 9][0] * inv, sc[(2 * u + 1) % 9][1] * inv); pw.w = pk2(sc[(2 * u + 1) % 9][2] * inv, sc[(2 * u + 1) % 9][3] * inv); }
        else { pw.z = 0u; pw.w = 0u; }
        const bf16x8 pb = as_bf16x8(pw);
#pragma unroll
        for (int mi = 0; mi < 4; ++mi) {
            const s16x4 v0 = vq[u][mi][0], v1 = vq[u][mi][1];
            const bf16x8 va = (bf16x8){v0[0], v0[1], v0[2], v0[3], v1[0], v1[1], v1[2], v1[3]};
            o[mi] = MFMA16(va, pb, o[mi]);
        }
    }
#pragma unroll
    for (int mi = 0; mi < 4; ++mi) {
        const int col = h * 64 + mi * 16 + 4 * g;
        const u32x2 gw = *(const u32x2*)(z + tokq * EIN + 1280 + col);
        u32x2 w; w.x = pk2(o[mi][0] * bf_lo(gw.x), o[mi][1] * bf_hi(gw.x)); w.y = pk2(o[mi][2] * bf_lo(gw.y), o[mi][3] * bf_hi(gw.y));
        *(u32x2*)(mix + tokq * 2048 + col) = w;
    }
}

__device__ __forceinline__ void attn_sample_item(LAS float* wl, const bf16_t* z, bf16_t* mix, const float* sinks, const float* ck, const float* cv, int it, int lane) {
    const int h = it & 15, b = it >> 4, kv = h >> 3;
    LAS float* qs = wl;
    LAS float* pT = wl + 512;
    const size_t tok0 = (size_t)T_P + b * 8;
#pragma unroll
    for (int t = 0; t < 8; ++t) qs[t * 64 + lane] = bf1(z[(tok0 + t) * EIN + h * 64 + lane]);
    __builtin_amdgcn_wave_barrier();
    asm volatile("s_waitcnt lgkmcnt(0)" ::: "memory");
    const float slope = exp2f(-0.5f * (float)(h + 1)), sink = sinks[h];
    float s[3][8];
#pragma unroll
    for (int ps = 0; ps < 3; ++ps) {
        const int idx = lane + 64 * ps;
#pragma unroll
        for (int t = 0; t < 8; ++t) s[ps][t] = 0.f;
        if (idx < 128) {
            const f32x4* kp = (const f32x4*)(ck + (((size_t)b * 128 + idx) * 2 + kv) * 64);
#pragma unroll 8
            for (int d4 = 0; d4 < 16; ++d4) {
                const f32x4 k4 = kp[d4];
#pragma unroll
                for (int t = 0; t < 8; ++t) { const f32x4 q4 = *(const LAS f32x4*)(qs + t * 64 + 4 * d4); s[ps][t] += (k4[0] * q4[0] + k4[1] * q4[1]) + (k4[2] * q4[2] + k4[3] * q4[3]); }
            }
        } else if (idx < 136) {
            const bf16_t* kp = z + (tok0 + (idx - 128)) * EIN + 1024 + kv * 64;
#pragma unroll 4
            for (int d4 = 0; d4 < 16; ++d4) {
                const u32x2 kw = *(const u32x2*)(kp + 4 * d4);
                const float k0 = bf_lo(kw.x), k1 = bf_hi(kw.x), k2 = bf_lo(kw.y), k3 = bf_hi(kw.y);
#pragma unroll
                for (int t = 0; t < 8; ++t) { const f32x4 q4 = *(const LAS f32x4*)(qs + t * 64 + 4 * d4); s[ps][t] += (k0 * q4[0] + k1 * q4[1]) + (k2 * q4[2] + k3 * q4[3]); }
            }
        }
#pragma unroll
        for (int t = 0; t < 8; ++t) {
            const int dist = t + 128 - idx;
            const bool valid = (idx < 136) && (dist >= 0) && (dist < 128);
            s[ps][t] = valid ? s[ps][t] * 0.125f - slope * (float)dist : -1e30f;
        }
    }
#pragma unroll
    for (int t = 0; t < 8; ++t) {
        float m = fmaxf(fmaxf(s[0][t], s[1][t]), s[2][t]); m = fmaxf(wave_max(m), sink);
        const float p0 = __expf(s[0][t] - m), p1 = __expf(s[1][t] - m), p2 = __expf(s[2][t] - m);
        const float den = wave_sum(p0 + p1 + p2) + __expf(sink - m), inv = 1.0f / den;
        pT[lane * 8 + t] = p0 * inv; pT[(lane + 64) * 8 + t] = p1 * inv; if (lane < 8) pT[(lane + 128) * 8 + t] = p2 * inv;
    }
    __builtin_amdgcn_wave_barrier();
    asm volatile("s_waitcnt lgkmcnt(0)" ::: "memory");
    float o[8];
#pragma unroll
    for (int t = 0; t < 8; ++t) o[t] = 0.f;
    for (int i0 = 0; i0 < 128; i0 += 16) {
        float vv[16];
#pragma unroll
        for (int j = 0; j < 16; ++j) vv[j] = cv[(((size_t)b * 128 + i0 + j) * 2 + kv) * 64 + lane];
#pragma unroll
        for (int j = 0; j < 16; ++j) {
        const int idx = i0 + j; const float v = vv[j];
        const f32x4 pa = *(const LAS f32x4*)(pT + idx * 8), pb = *(const LAS f32x4*)(pT + idx * 8 + 4);
        o[0] += pa[0] * v; o[1] += pa[1] * v; o[2] += pa[2] * v; o[3] += pa[3] * v; o[4] += pb[0] * v; o[5] += pb[1] * v; o[6] += pb[2] * v; o[7] += pb[3] * v;
        }
    }
#pragma unroll
    for (int idx = 128; idx < 136; ++idx) {
        const float v = bf1(z[(tok0 + (idx - 128)) * EIN + 1152 + kv * 64 + lane]);
        const f32x4 pa = *(const LAS f32x4*)(pT + idx * 8), pb = *(const LAS f32x4*)(pT + idx * 8 + 4);
        o[0] += pa[0] * v; o[1] += pa[1] * v; o[2] += pa[2] * v; o[3] += pa[3] * v; o[4] += pb[0] * v; o[5] += pb[1] * v; o[6] += pb[2] * v; o[7] += pb[3] * v;
    }
#pragma unroll
    for (int t = 0; t < 8; ++t) {
        const float ga = bf1(z[(tok0 + t) * EIN + 1280 + h * 64 + lane]);
        mix[(tok0 + t) * 2048 + h * 64 + lane] = f2bf(o[t] * ga);
    }
    __builtin_amdgcn_wave_barrier();
}

__device__ __forceinline__ void gate_prompt_item(LAS unsigned char* lds, const bf16_t* z, bf16_t* mix, const float* w_s, const float* b_s,
                                                 const float* lnv_g, const float* lnv_b, int item, int tid) {
    const int gr = item & 3, n = (item >> 2) & 31, b = item >> 7;
    const int wave = tid >> 6, lane = tid & 63, l15 = lane & 15, g = lane >> 4, q4 = l15 >> 2, p4 = lane & 3;
    const size_t tok0 = (size_t)b * SEQL + n * 128;
    LAS float* stat = (LAS float*)lds;
    LAS unsigned char* vn = lds + 1024;
#pragma unroll 2
    for (int r = 0; r < 16; ++r) {
        const int row = 16 * wave + r;
        const bf16_t* vp = z + (tok0 + row) * EIN + 3328 + lane * 16;
        const u32x4 a = *(const u32x4*)vp, c = *(const u32x4*)(vp + 8);
        float v[16] = {bf_lo(a.x), bf_hi(a.x), bf_lo(a.y), bf_hi(a.y), bf_lo(a.z), bf_hi(a.z), bf_lo(a.w), bf_hi(a.w),
                       bf_lo(c.x), bf_hi(c.x), bf_lo(c.y), bf_hi(c.y), bf_lo(c.z), bf_hi(c.z), bf_lo(c.w), bf_hi(c.w)};
        float s = 0.f;
#pragma unroll
        for (int e = 0; e < 16; ++e) s += v[e];
        const float mean = wave_sum(s) * (1.0f / 1024.0f);
        float q = 0.f;
#pragma unroll
        for (int e = 0; e < 16; ++e) { const float d = v[e] - mean; q += d * d; }
        const float rstd = rsqrtf(wave_sum(q) * (1.0f / 1024.0f) + EPSN);
        if (lane == 0) { stat[row * 2] = mean; stat[row * 2 + 1] = rstd; }
    }
    __syncthreads();
#pragma unroll
    for (int i = 0; i < 8; ++i) {
        const int idx = tid + 512 * i, row = idx >> 5, ch = idx & 31;
        const u32x4 a = *(const u32x4*)(z + (tok0 + row) * EIN + 3328 + gr * 256 + ch * 8);
        const f32x4 g0 = *(const f32x4*)(lnv_g + gr * 256 + ch * 8), g1 = *(const f32x4*)(lnv_g + gr * 256 + ch * 8 + 4);
        const f32x4 b0 = *(const f32x4*)(lnv_b + gr * 256 + ch * 8), b1 = *(const f32x4*)(lnv_b + gr * 256 + ch * 8 + 4);
        const float mean = stat[row * 2], rstd = stat[row * 2 + 1];
        u32x4 w;
        w.x = pk2((bf_lo(a.x) - mean) * rstd * g0[0] + b0[0], (bf_hi(a.x) - mean) * rstd * g0[1] + b0[1]);
        w.y = pk2((bf_lo(a.y) - mean) * rstd * g0[2] + b0[2], (bf_hi(a.y) - mean) * rstd * g0[3] + b0[3]);
        w.z = pk2((bf_lo(a.z) - mean) * rstd * g1[0] + b1[0], (bf_hi(a.z) - mean) * rstd * g1[1] + b1[1]);
        w.w = pk2((bf_lo(a.w) - mean) * rstd * g1[2] + b1[2], (bf_hi(a.w) - mean) * rstd * g1[3] + b1[3]);
        *(LAS u32x4*)(vn + row * 528 + ch * 16) = w;
    }
    __syncthreads();
    const int i = 16 * wave + l15, nks = (wave >> 1) + 1;
    bf16x8 bfr[4];
#pragma unroll
    for (int ks = 0; ks < 4; ++ks) {
        u32x4 w = {0u, 0u, 0u, 0u};
        if (ks < nks) {
            const int j0 = 32 * ks + 8 * g;
            const float* wp = w_s + ((size_t)gr * 128 + i) * 128 + j0;
            const f32x4 a = *(const f32x4*)wp, c = *(const f32x4*)(wp + 4);
            w.x = pk2(j0 + 0 <= i ? a[0] : 0.f, j0 + 1 <= i ? a[1] : 0.f); w.y = pk2(j0 + 2 <= i ? a[2] : 0.f, j0 + 3 <= i ? a[3] : 0.f);
            w.z = pk2(j0 + 4 <= i ? c[0] : 0.f, j0 + 5 <= i ? c[1] : 0.f); w.w = pk2(j0 + 6 <= i ? c[2] : 0.f, j0 + 7 <= i ? c[3] : 0.f);
        }
        bfr[ks] = as_bf16x8(w);
    }
    const float bias = b_s[gr * 128 + i];
    const size_t tok = tok0 + i;
    u32x2 uq[16], gq[16];
#pragma unroll
    for (int ct = 0; ct < 16; ++ct) { const int col = gr * 256 + 16 * ct + 4 * g; uq[ct] = *(const u32x2*)(z + tok * EIN + 2304 + col); gq[ct] = *(const u32x2*)(z + tok * EIN + 4352 + col); }
#pragma unroll
    for (int ct = 0; ct < 16; ++ct) {
        f32x4 acc = {0.f, 0.f, 0.f, 0.f};
#pragma unroll
        for (int ks = 0; ks < 4; ++ks)
            if (ks < nks) {
                LAS unsigned char* ap = vn + (32 * ks + 8 * g + q4) * 528 + (16 * ct + 4 * p4) * 2;
                const bf16x8 a = tr_read8(ap, ap + 4 * 528);
                acc = MFMA16(a, bfr[ks], acc);
            }
        const int col = gr * 256 + 16 * ct + 4 * g;
        const u32x2 uw = uq[ct], gw = gq[ct];
        u32x2 w;
        w.x = pk2(bf_lo(gw.x) * bf_lo(uw.x) * (acc[0] + bias), bf_hi(gw.x) * bf_hi(uw.x) * (acc[1] + bias));
        w.y = pk2(bf_lo(gw.y) * bf_lo(uw.y) * (acc[2] + bias), bf_hi(gw.y) * bf_hi(uw.y) * (acc[3] + bias));
        *(u32x2*)(mix + tok * 2048 + 1024 + col) = w;
    }
    __syncthreads();
}

__device__ __forceinline__ void gate_sample_item(const bf16_t* z, bf16_t* mix, float* cvs  , const float* w_s, const float* b_s,
                                                 const float* lnv_g, const float* lnv_b, int it, int lane) {
    const int cq = it & 7, b = it >> 3, gr = cq >> 1;
    const size_t tok0 = (size_t)T_P + b * 8;
    const int c = cq * 128 + 2 * lane;
    float vn0[8], vn1[8];
#pragma unroll
    for (int j = 0; j < 8; ++j) {
        const bf16_t* vp = z + (tok0 + j) * EIN + 3328 + lane * 16;
        const u32x4 a = *(const u32x4*)vp, cc = *(const u32x4*)(vp + 8);
        float v[16] = {bf_lo(a.x), bf_hi(a.x), bf_lo(a.y), bf_hi(a.y), bf_lo(a.z), bf_hi(a.z), bf_lo(a.w), bf_hi(a.w),
                       bf_lo(cc.x), bf_hi(cc.x), bf_lo(cc.y), bf_hi(cc.y), bf_lo(cc.z), bf_hi(cc.z), bf_lo(cc.w), bf_hi(cc.w)};
        float s = 0.f;
#pragma unroll
        for (int e = 0; e < 16; ++e) s += v[e];
        const float mean = wave_sum(s) * (1.0f / 1024.0f);
        float q = 0.f;
#pragma unroll
        for (int e = 0; e < 16; ++e) { const float d = v[e] - mean; q += d * d; }
        const float rstd = rsqrtf(wave_sum(q) * (1.0f / 1024.0f) + EPSN);
        const unsigned xw = *(const unsigned*)(z + (tok0 + j) * EIN + 3328 + c);
        vn0[j] = (bf_lo(xw) - mean) * rstd * lnv_g[c] + lnv_b[c];
        vn1[j] = (bf_hi(xw) - mean) * rstd * lnv_g[c + 1] + lnv_b[c + 1];
        *(f32x2*)(cvs + ((size_t)b * 8 + j) * 1024 + c) = (f32x2){vn0[j], vn1[j]};
    }
#pragma unroll
    for (int t = 0; t < 8; ++t) {
        float m0 = b_s[gr * 128 + t], m1 = m0;
#pragma unroll
        for (int j = 0; j < 8; ++j)
            if (j <= t) { const float w = w_s[((size_t)gr * 128 + t) * 128 + j]; m0 += w * vn0[j]; m1 += w * vn1[j]; }
        const unsigned uw = *(const unsigned*)(z + (tok0 + t) * EIN + 2304 + c), gw = *(const unsigned*)(z + (tok0 + t) * EIN + 4352 + c);
        *(unsigned*)(mix + (tok0 + t) * 2048 + 1024 + c) = pk2(bf_lo(gw) * bf_lo(uw) * m0, bf_hi(gw) * bf_hi(uw) * m1);
    }
}

__device__ __forceinline__ void ret_prompt_item(LAS unsigned char* lds, const bf16_t* z, bf16_t* o, float* state_out, int item, int tid) {
    const int et = item & 7, h = (item >> 3) & 7, b = item >> 6;
    const int wave = tid >> 6, lane = tid & 63, l15 = lane & 15, g = lane >> 4, q4 = l15 >> 2, p4 = lane & 3;
    const float lg = log1pf(-exp2f(-5.0f - (float)h));
    LAS unsigned char* Kn = lds;
    LAS unsigned char* Vn = lds + 67584;
    LAS unsigned char* Vd = Vn + 18432;
    LAS unsigned char* St = Vd + 18432;
    for (int idx = tid; idx < 33792 / 4; idx += NTHREADS) ((LAS unsigned*)St)[idx] = 0u;
    f32x4 accS[4][2];
#pragma unroll
    for (int e4 = 0; e4 < 4; ++e4) { accS[e4][0] = (f32x4){0.f, 0.f, 0.f, 0.f}; accS[e4][1] = (f32x4){0.f, 0.f, 0.f, 0.f}; }
    const float g128 = expf(128.0f * lg);
    const int itw = (wave < 4) ? wave : 11 - wave;
    const int i = 16 * itw + l15;
    const float qd = expf((float)(i + 1) * lg);
    const float lg2 = lg * 1.44269504089f;
    u32x4 kreg[8], vreg[2];
    {
        const size_t tk = (size_t)b * SEQL;
#pragma unroll
        for (int r = 0; r < 8; ++r) { const int idx = tid + 512 * r, row = idx >> 5, ch = idx & 31; kreg[r] = *(const u32x4*)(z + (tk + row) * RIN + 2048 + h * 256 + ch * 8); }
#pragma unroll
        for (int r = 0; r < 2; ++r) { const int idx = tid + 512 * r, row = idx >> 3, ch = idx & 7; vreg[r] = *(const u32x4*)(z + (tk + row) * RIN + 4096 + h * 512 + et * 64 + ch * 8); }
    }
    for (int c = 0; c < 32; ++c) {
        const size_t tok0 = (size_t)b * SEQL + c * 128;
        bf16x8 qf[8];
#pragma unroll
        for (int ks = 0; ks < 8; ++ks) qf[ks] = *(const bf16x8*)(z + (tok0 + i) * RIN + h * 256 + 32 * ks + 8 * g);
        __syncthreads();
#pragma unroll
        for (int r = 0; r < 8; ++r) { const int idx = tid + 512 * r, row = idx >> 5, ch = idx & 31; *(LAS u32x4*)(Kn + row * 528 + ch * 16) = kreg[r]; }
#pragma unroll
        for (int r = 0; r < 2; ++r) {
            const int idx = tid + 512 * r, row = idx >> 3, ch = idx & 7;
            const u32x4 v = vreg[r];
            *(LAS u32x4*)(Vn + row * 144 + ch * 16) = v;
            const float dec = __builtin_amdgcn_exp2f((float)(127 - row) * lg2);
            u32x4 w; w.x = pk2(bf_lo(v.x) * dec, bf_hi(v.x) * dec); w.y = pk2(bf_lo(v.y) * dec, bf_hi(v.y) * dec);
            w.z = pk2(bf_lo(v.z) * dec, bf_hi(v.z) * dec); w.w = pk2(bf_lo(v.w) * dec, bf_hi(v.w) * dec);
            *(LAS u32x4*)(Vd + row * 144 + ch * 16) = w;
        }
        __syncthreads();
        if (c + 1 < 32) {
            const size_t tk = tok0 + 128;
#pragma unroll
            for (int r = 0; r < 8; ++r) { const int idx = tid + 512 * r, row = idx >> 5, ch = idx & 31; kreg[r] = *(const u32x4*)(z + (tk + row) * RIN + 2048 + h * 256 + ch * 8); }
#pragma unroll
            for (int r = 0; r < 2; ++r) { const int idx = tid + 512 * r, row = idx >> 3, ch = idx & 7; vreg[r] = *(const u32x4*)(z + (tk + row) * RIN + 4096 + h * 512 + et * 64 + ch * 8); }
        }
        f32x4 ao[4];
#pragma unroll
        for (int e4 = 0; e4 < 4; ++e4) {
            f32x4 a = {0.f, 0.f, 0.f, 0.f};
#pragma unroll
            for (int ks = 0; ks < 8; ++ks) { const bf16x8 sa = *(const LAS bf16x8*)(St + (16 * e4 + l15) * 528 + (32 * ks + 8 * g) * 2); a = MFMA16(sa, qf[ks], a); }
            ao[e4] = a * qd;
        }
#pragma unroll 1
        for (int u = 0; u < 4; ++u) {
            if (2 * u <= itw) {
                f32x4 p0 = {0.f, 0.f, 0.f, 0.f}, p1 = {0.f, 0.f, 0.f, 0.f};
#pragma unroll
                for (int ks = 0; ks < 8; ++ks) { const bf16x8 ka = *(const LAS bf16x8*)(Kn + (32 * u + l15) * 528 + (32 * ks + 8 * g) * 2); p0 = MFMA16(ka, qf[ks], p0); }
                if (2 * u + 1 <= itw) {
#pragma unroll
                    for (int ks = 0; ks < 8; ++ks) { const bf16x8 ka = *(const LAS bf16x8*)(Kn + (32 * u + 16 + l15) * 528 + (32 * ks + 8 * g) * 2); p1 = MFMA16(ka, qf[ks], p1); }
                }
                float d0[4], d1[4];
#pragma unroll
                for (int jj = 0; jj < 4; ++jj) {
                    const int j0 = 32 * u + 4 * g + jj, j1 = j0 + 16;
                    d0[jj] = (i >= j0) ? p0[jj] * __builtin_amdgcn_exp2f((float)(i - j0) * lg2) : 0.f;
                    d1[jj] = (i >= j1) ? p1[jj] * __builtin_amdgcn_exp2f((float)(i - j1) * lg2) : 0.f;
                }
                u32x4 pw; pw.x = pk2(d0[0], d0[1]); pw.y = pk2(d0[2], d0[3]); pw.z = pk2(d1[0], d1[1]); pw.w = pk2(d1[2], d1[3]);
                const bf16x8 pb = as_bf16x8(pw);
#pragma unroll
                for (int e4 = 0; e4 < 4; ++e4) {
                    LAS unsigned char* ap = Vn + (32 * u + 4 * g + q4) * 144 + (16 * e4 + 4 * p4) * 2;
                    const bf16x8 va = tr_read8(ap, ap + 16 * 144);
                    ao[e4] = MFMA16(va, pb, ao[e4]);
                }
            }
        }
#pragma unroll
        for (int e4 = 0; e4 < 4; ++e4) {
            u32x2 w; w.x = pk2(ao[e4][0], ao[e4][1]); w.y = pk2(ao[e4][2], ao[e4][3]);
            *(u32x2*)(o + (tok0 + i) * 4096 + h * 512 + et * 64 + 16 * e4 + 4 * g) = w;
        }
        __syncthreads();
#pragma unroll
        for (int e4 = 0; e4 < 4; ++e4) { accS[e4][0] = accS[e4][0] * g128; accS[e4][1] = accS[e4][1] * g128; }
#pragma unroll
        for (int ks = 0; ks < 4; ++ks) {
            bf16x8 kb[2];
#pragma unroll
            for (int dt = 0; dt < 2; ++dt) { LAS unsigned char* bp = Kn + (32 * ks + 8 * g + q4) * 528 + (16 * (2 * wave + dt) + 4 * p4) * 2; kb[dt] = tr_read8(bp, bp + 4 * 528); }
#pragma unroll
            for (int e4 = 0; e4 < 4; ++e4) {
                LAS unsigned char* ap = Vd + (32 * ks + 8 * g + q4) * 144 + (16 * e4 + 4 * p4) * 2;
                const bf16x8 va = tr_read8(ap, ap + 4 * 144);
                accS[e4][0] = MFMA16(kb[0], va, accS[e4][0]); accS[e4][1] = MFMA16(kb[1], va, accS[e4][1]);
            }
        }
#pragma unroll
        for (int e4 = 0; e4 < 4; ++e4)
#pragma unroll
            for (int dt = 0; dt < 2; ++dt)
            { u32x2 w; w.x = pk2(accS[e4][dt][0], accS[e4][dt][1]); w.y = pk2(accS[e4][dt][2], accS[e4][dt][3]);
                *(LAS u32x2*)(St + (16 * e4 + l15) * 528 + (16 * (2 * wave + dt) + 4 * g) * 2) = w; }
    }
#pragma unroll
    for (int e4 = 0; e4 < 4; ++e4)
#pragma unroll
        for (int dt = 0; dt < 2; ++dt) {
#pragma unroll
            for (int jj = 0; jj < 4; ++jj) { const int d = 16 * (2 * wave + dt) + 4 * g + jj;
                state_out[((size_t)(b * 8 + h) * 256 + d) * 512 + et * 64 + 16 * e4 + l15] = accS[e4][dt][jj]; }
        }
    __syncthreads();
}

__device__ __forceinline__ void ret_sample_item(LAS unsigned char* lds, const bf16_t* z, bf16_t* o, const float* S_in, float* S_out, int item, int tid) {
    const int h = item & 7, b = item >> 3;
    const float lg = log1pf(-exp2f(-5.0f - (float)h));
    LAS float* qs = (LAS float*)lds;
    LAS float* ks = qs + 2048;
    LAS float* scs = ks + 2048;
    LAS float* red = scs + 64;
    const size_t tok0 = (size_t)T_P + b * 8;
    {
        const int t = tid >> 6, ln = tid & 63;
        const u32x2 qw = *(const u32x2*)(z + (tok0 + t) * RIN + h * 256 + 4 * ln), kw = *(const u32x2*)(z + (tok0 + t) * RIN + 2048 + h * 256 + 4 * ln);
        qs[(4 * ln + 0) * 8 + t] = bf_lo(qw.x); qs[(4 * ln + 1) * 8 + t] = bf_hi(qw.x); qs[(4 * ln + 2) * 8 + t] = bf_lo(qw.y); qs[(4 * ln + 3) * 8 + t] = bf_hi(qw.y);
        ks[(4 * ln + 0) * 8 + t] = bf_lo(kw.x); ks[(4 * ln + 1) * 8 + t] = bf_hi(kw.x); ks[(4 * ln + 2) * 8 + t] = bf_lo(kw.y); ks[(4 * ln + 3) * 8 + t] = bf_hi(kw.y);
    }
    __syncthreads();
    if (tid < 64) {
        const int t = tid >> 3, s = tid & 7; float a = 0.f;
        for (int d = 0; d < 256; ++d) a += qs[d * 8 + t] * ks[d * 8 + s];
        scs[t * 8 + s] = (t >= s) ? a * expf((float)(t - s) * lg) : 0.f;
    }
    const int eg = tid & 127, dq = tid >> 7, e = 4 * eg;
    f32x4 vd[8], cr[8];
#pragma unroll
    for (int s = 0; s < 8; ++s) {
        const u32x2 vw = *(const u32x2*)(z + (tok0 + s) * RIN + 4096 + h * 512 + e);
        const float dec = expf((float)(7 - s) * lg);
        vd[s] = (f32x4){bf_lo(vw.x) * dec, bf_hi(vw.x) * dec, bf_lo(vw.y) * dec, bf_hi(vw.y) * dec};
        cr[s] = (f32x4){0.f, 0.f, 0.f, 0.f};
    }
    const float g8 = expf(8.0f * lg);
    const float* sp = S_in + (((size_t)(b * 8 + h) * 256 + dq * 64) * 512 + e);
    float* dp = S_out + (((size_t)(b * 8 + h) * 256 + dq * 64) * 512 + e);
    for (int dd0 = 0; dd0 < 64; dd0 += 16) {
        f32x4 Sv[16];
#pragma unroll
        for (int j = 0; j < 16; ++j) Sv[j] = __builtin_nontemporal_load((const f32x4*)(sp + (size_t)(dd0 + j) * 512));
#pragma unroll
        for (int j = 0; j < 16; ++j) {
            const int d = dq * 64 + dd0 + j;
            const f32x4 S4 = Sv[j];
            const f32x4 qa = *(const LAS f32x4*)(qs + d * 8), qb = *(const LAS f32x4*)(qs + d * 8 + 4);
            const f32x4 ka = *(const LAS f32x4*)(ks + d * 8), kb = *(const LAS f32x4*)(ks + d * 8 + 4);
            cr[0] += qa[0] * S4; cr[1] += qa[1] * S4; cr[2] += qa[2] * S4; cr[3] += qa[3] * S4;
            cr[4] += qb[0] * S4; cr[5] += qb[1] * S4; cr[6] += qb[2] * S4; cr[7] += qb[3] * S4;
            f32x4 ns = S4 * g8;
            ns += ka[0] * vd[0]; ns += ka[1] * vd[1]; ns += ka[2] * vd[2]; ns += ka[3] * vd[3];
            ns += kb[0] * vd[4]; ns += kb[1] * vd[5]; ns += kb[2] * vd[6]; ns += kb[3] * vd[7];
            __builtin_nontemporal_store(ns, (f32x4*)(dp + (size_t)(dd0 + j) * 512));
        }
    }
#pragma unroll
    for (int t = 0; t < 8; ++t) *(LAS f32x4*)(red + ((dq * 8 + t) * 512 + e)) = cr[t];
    __syncthreads();
    {
        const int t = tid >> 6, e8 = (tid & 63) * 8;
        const float qd = expf((float)(t + 1) * lg);
        float acc[8];
#pragma unroll
        for (int j = 0; j < 8; ++j) acc[j] = 0.f;
#pragma unroll
        for (int q = 0; q < 4; ++q) {
            const f32x4 a = *(const LAS f32x4*)(red + ((q * 8 + t) * 512 + e8)), c = *(const LAS f32x4*)(red + ((q * 8 + t) * 512 + e8 + 4));
            acc[0] += a[0]; acc[1] += a[1]; acc[2] += a[2]; acc[3] += a[3]; acc[4] += c[0]; acc[5] += c[1]; acc[6] += c[2]; acc[7] += c[3];
        }
#pragma unroll
        for (int j = 0; j < 8; ++j) acc[j] *= qd;
#pragma unroll
        for (int s = 0; s < 8; ++s) {
            const float w = scs[t * 8 + s];
            const u32x4 vw = *(const u32x4*)(z + (tok0 + s) * RIN + 4096 + h * 512 + e8);
            acc[0] += w * bf_lo(vw.x); acc[1] += w * bf_hi(vw.x); acc[2] += w * bf_lo(vw.y); acc[3] += w * bf_hi(vw.y);
            acc[4] += w * bf_lo(vw.z); acc[5] += w * bf_hi(vw.z); acc[6] += w * bf_lo(vw.w); acc[7] += w * bf_hi(vw.w);
        }
        u32x4 w; w.x = pk2(acc[0], acc[1]); w.y = pk2(acc[2], acc[3]); w.z = pk2(acc[4], acc[5]); w.w = pk2(acc[6], acc[7]);
        *(u32x4*)(o + (tok0 + t) * 4096 + h * 512 + e8) = w;
    }
    __syncthreads();
}

__device__ __forceinline__ void xattn_prompt_item(const bf16_t* xq, const bf16_t* xq1, const bf16_t* memkv, const bf16_t* memvt, bf16_t* xo, int l, int it, int lane) {
    const int h = it & 3, qt = it >> 2, b = qt >> 8;
    const int l15 = lane & 15, g = lane >> 4;
    const size_t tok = (size_t)qt * 16 + l15;
    bf16x8 qf[4];
#pragma unroll
    for (int ks = 0; ks < 4; ++ks) {
        const u32x4 a = *(const u32x4*)(xq + tok * 512 + h * 128 + 32 * ks + 8 * g), c = *(const u32x4*)(xq1 + tok * 512 + h * 128 + 32 * ks + 8 * g);
        u32x4 w; w.x = pk2(bf_lo(a.x) + bf_lo(c.x), bf_hi(a.x) + bf_hi(c.x)); w.y = pk2(bf_lo(a.y) + bf_lo(c.y), bf_hi(a.y) + bf_hi(c.y));
        w.z = pk2(bf_lo(a.z) + bf_lo(c.z), bf_hi(a.z) + bf_hi(c.z)); w.w = pk2(bf_lo(a.w) + bf_lo(c.w), bf_hi(a.w) + bf_hi(c.w));
        qf[ks] = as_bf16x8(w);
    }
    f32x4 sc[16];
    float mx = -1e30f;
#pragma unroll
    for (int kt = 0; kt < 16; ++kt) {
        const bf16_t* kp = memkv + ((size_t)b * 256 + 16 * kt + l15) * 4096 + l * 1024 + h * 128 + 8 * g;
        f32x4 a = {0.f, 0.f, 0.f, 0.f};
#pragma unroll
        for (int ks = 0; ks < 4; ++ks) a = MFMA16(*(const bf16x8*)(kp + 32 * ks), qf[ks], a);
        a = a * 0.08838834764831845f;
        sc[kt] = a; mx = fmaxf(fmaxf(mx, fmaxf(a[0], a[1])), fmaxf(a[2], a[3]));
    }
    mx = fmaxf(mx, __shfl_xor(mx, 16)); mx = fmaxf(mx, __shfl_xor(mx, 32));
    float sum = 0.f;
#pragma unroll
    for (int kt = 0; kt < 16; ++kt)
#pragma unroll
        for (int j = 0; j < 4; ++j) { const float p = __expf(sc[kt][j] - mx); sc[kt][j] = p; sum += p; }
    sum += __shfl_xor(sum, 16); sum += __shfl_xor(sum, 32);
    const float inv = 1.0f / sum;
    f32x4 o[8];
#pragma unroll
    for (int mi = 0; mi < 8; ++mi) o[mi] = (f32x4){0.f, 0.f, 0.f, 0.f};
#pragma unroll
    for (int u = 0; u < 8; ++u) {
        u32x4 pw; pw.x = pk2(sc[2 * u][0] * inv, sc[2 * u][1] * inv); pw.y = pk2(sc[2 * u][2] * inv, sc[2 * u][3] * inv);
        pw.z = pk2(sc[2 * u + 1][0] * inv, sc[2 * u + 1][1] * inv); pw.w = pk2(sc[2 * u + 1][2] * inv, sc[2 * u + 1][3] * inv);
        const bf16x8 pb = as_bf16x8(pw);
        const int pos0 = 32 * u + 4 * g;
#pragma unroll
        for (int mi = 0; mi < 8; ++mi) {
            const bf16_t* vp = memvt + ((size_t)((l * 2 + b) * 512 + h * 128 + 16 * mi + l15)) * 256 + pos0;
            const s16x4 v0 = *(const s16x4*)vp, v1 = *(const s16x4*)(vp + 16);
            const bf16x8 va = (bf16x8){v0[0], v0[1], v0[2], v0[3], v1[0], v1[1], v1[2], v1[3]};
            o[mi] = MFMA16(va, pb, o[mi]);
        }
    }
#pragma unroll
    for (int mi = 0; mi < 8; ++mi) {
        u32x2 w; w.x = pk2(o[mi][0], o[mi][1]); w.y = pk2(o[mi][2], o[mi][3]);
        *(u32x2*)(xo + tok * 512 + h * 128 + 16 * mi + 4 * g) = w;
    }
}

__device__ __forceinline__ void xattn_sample_item(LAS float* wl, const bf16_t* xq, const float* mk, const float* mv, bf16_t* xo, int it, int lane) {
    const int h = it & 3, b = it >> 2;
    LAS float* qs = wl;
    LAS float* pT = wl + 1024;
    const size_t tok0 = (size_t)T_P + b * 8;
#pragma unroll
    for (int t = 0; t < 8; ++t) {
        const unsigned qw = *(const unsigned*)(xq + (tok0 + t) * 512 + h * 128 + 2 * lane);
        *(LAS f32x2*)(qs + t * 128 + 2 * lane) = (f32x2){bf_lo(qw) * 0.08838834764831845f, bf_hi(qw) * 0.08838834764831845f};
    }
    __builtin_amdgcn_wave_barrier();
    asm volatile("s_waitcnt lgkmcnt(0)" ::: "memory");
    float s[4][8];
#pragma unroll
    for (int ps = 0; ps < 4; ++ps) {
        const int key = lane + 64 * ps;
#pragma unroll
        for (int t = 0; t < 8; ++t) s[ps][t] = 0.f;
        const f32x4* kp = (const f32x4*)(mk + (((size_t)b * 256 + key) * 4 + h) * 128);
#pragma unroll 4
        for (int d4 = 0; d4 < 32; ++d4) {
            const f32x4 k4 = kp[d4];
#pragma unroll
            for (int t = 0; t < 8; ++t) { const f32x4 q4 = *(const LAS f32x4*)(qs + t * 128 + 4 * d4); s[ps][t] += (k4[0] * q4[0] + k4[1] * q4[1]) + (k4[2] * q4[2] + k4[3] * q4[3]); }
        }
    }
#pragma unroll
    for (int t = 0; t < 8; ++t) {
        float m = fmaxf(fmaxf(s[0][t], s[1][t]), fmaxf(s[2][t], s[3][t])); m = wave_max(m);
        const float p0 = __expf(s[0][t] - m), p1 = __expf(s[1][t] - m), p2 = __expf(s[2][t] - m), p3 = __expf(s[3][t] - m);
        const float inv = 1.0f / wave_sum((p0 + p1) + (p2 + p3));
        pT[lane * 8 + t] = p0 * inv; pT[(lane + 64) * 8 + t] = p1 * inv; pT[(lane + 128) * 8 + t] = p2 * inv; pT[(lane + 192) * 8 + t] = p3 * inv;
    }
    __builtin_amdgcn_wave_barrier();
    asm volatile("s_waitcnt lgkmcnt(0)" ::: "memory");
    f32x2 o[8];
#pragma unroll
    for (int t = 0; t < 8; ++t) o[t] = (f32x2){0.f, 0.f};
#pragma unroll 4
    for (int key = 0; key < 256; ++key) {
        const f32x2 v = *(const f32x2*)(mv + (((size_t)b * 256 + key) * 4 + h) * 128 + 2 * lane);
        const f32x4 pa = *(const LAS f32x4*)(pT + key * 8), pb = *(const LAS f32x4*)(pT + key * 8 + 4);
        o[0] += pa[0] * v; o[1] += pa[1] * v; o[2] += pa[2] * v; o[3] += pa[3] * v; o[4] += pb[0] * v; o[5] += pb[1] * v; o[6] += pb[2] * v; o[7] += pb[3] * v;
    }
#pragma unroll
    for (int t = 0; t < 8; ++t) *(unsigned*)(xo + (tok0 + t) * 512 + h * 128 + 2 * lane) = pk2(o[t][0], o[t][1]);
    __builtin_amdgcn_wave_barrier();
}

#define XB_TMO      128
#define XB_XCNT(j)  (256  + 64 * (j))
#define XB_XSUB(j)  (1280 + 64 * (j))
#define XB_XGEN(j)  (2304 + 64 * (j))
#define XB_TOP      3328
#define XB_TOPGEN   3392
#define XCD_BAR_WORDS 3456
#define XB_SPIN_CAP (1u << 18)

__device__ __forceinline__ unsigned xb_ld(unsigned* p)              { return __hip_atomic_load(p, __ATOMIC_RELAXED, __HIP_MEMORY_SCOPE_AGENT); }
__device__ __forceinline__ unsigned xb_add(unsigned* p, unsigned v) { return __hip_atomic_fetch_add(p, v, __ATOMIC_RELAXED, __HIP_MEMORY_SCOPE_AGENT); }
__device__ __forceinline__ unsigned xb_xcc_id() { return (unsigned)__builtin_amdgcn_s_getreg((3 << 11) | 20) & 0xFu; }
#define XB_SPIN(cond, bar) do { unsigned _sp = 0; while (cond) { __builtin_amdgcn_s_sleep(1); \
    if ((++_sp & 255u) == 0u) { if (xb_ld(&(bar)[XB_TMO])) break; if (_sp > XB_SPIN_CAP) { atomicAdd(&(bar)[XB_TMO], 1u); break; } } } } while (0)

struct XcdBarrier {
    unsigned* bar; unsigned x;
    volatile LAS unsigned* st;
};

__device__ __forceinline__ XcdBarrier xcd_barrier_post(unsigned* bar, volatile LAS unsigned* st) {
    XcdBarrier b; b.bar = bar; b.x = xb_xcc_id(); b.st = st;
    if (threadIdx.x == 0) (void)xb_add(&bar[XB_XCNT(b.x)], 1u);
    return b;
}
__device__ __forceinline__ void xcd_barrier_complete(unsigned* bar, unsigned x, unsigned& nloc, unsigned& nx) {
    const unsigned G = gridDim.x * gridDim.y * gridDim.z;
    unsigned sum, cnt, mine, sp = 0u;
    for (;;) {
        sum = 0u; cnt = 0u; mine = 0u;
#pragma unroll
        for (unsigned j = 0; j < 16; ++j) { const unsigned c = xb_ld(&bar[XB_XCNT(j)]); sum += c; cnt += (c > 0u) ? 1u : 0u; mine = (j == x) ? c : mine; }
        if (sum == G) break;
        __builtin_amdgcn_s_sleep(1);
        if ((++sp & 255u) == 0u) { if (xb_ld(&bar[XB_TMO])) break; if (sp > XB_SPIN_CAP) { atomicAdd(&bar[XB_TMO], 1u); break; } }
    }
    nloc = mine > 0u ? mine : 1u; nx = cnt > 0u ? cnt : 1u;
}

__device__ __forceinline__ void xcd_barrier(const XcdBarrier& b) {
    asm volatile("s_waitcnt vmcnt(0)" ::: "memory");
    __syncthreads();
    if (threadIdx.x == 0) {
        unsigned* bar = b.bar;
        __builtin_amdgcn_s_waitcnt(0);
        unsigned nloc = b.st[0], nx = b.st[1];
        if (nloc == 0u) { xcd_barrier_complete(bar, b.x, nloc, nx); b.st[0] = nloc; b.st[1] = nx; }
        const unsigned old = xb_add(&bar[XB_XSUB(b.x)], 1u);
        const unsigned gen = old / nloc;
        if (old + 1u == (gen + 1u) * nloc) {
            __builtin_amdgcn_fence(__ATOMIC_RELEASE, "agent");
            asm volatile("s_waitcnt vmcnt(0)" ::: "memory");
            const unsigned og = xb_add(&bar[XB_TOP], 1u);
            const unsigned tg = og / nx;
            if (og + 1u == (tg + 1u) * nx) xb_add(&bar[XB_TOPGEN], 1u);
            else XB_SPIN(xb_ld(&bar[XB_TOPGEN]) == tg, bar);
            __builtin_amdgcn_fence(__ATOMIC_ACQUIRE, "agent");
            xb_add(&bar[XB_XGEN(b.x)], 1u);
            asm volatile("s_waitcnt vmcnt(0)" ::: "memory");
        } else {
            XB_SPIN(xb_ld(&bar[XB_XGEN(b.x)]) == gen, bar);
            __builtin_amdgcn_fence(__ATOMIC_ACQUIRE, "agent");
            asm volatile("s_waitcnt vmcnt(0)" ::: "memory");
        }
    }
    __syncthreads();
}


__device__ __forceinline__ void xattn_sample_block(LAS unsigned char* lds, const bf16_t* xq, const bf16_t* xq1, const float* mk, const float* mv, bf16_t* xo, int it, int tid) {
    const int h = it & 3, b = it >> 2, wave = tid >> 6, lane = tid & 63;
    LAS float* qs = (LAS float*)lds;
    LAS float* pT = qs + 1024;
    LAS float* ml = pT + 2048;
    LAS float* po = ml + 64;
    const size_t tok0 = (size_t)T_P + b * 8;
    if (wave < 4) {
#pragma unroll
        for (int t2 = 0; t2 < 2; ++t2) {
            const int t = wave * 2 + t2;
            const unsigned qw = *(const unsigned*)(xq + (tok0 + t) * 512 + h * 128 + 2 * lane), qw1 = *(const unsigned*)(xq1 + (tok0 + t) * 512 + h * 128 + 2 * lane);
            *(LAS f32x2*)(qs + t * 128 + 2 * lane) = (f32x2){(bf_lo(qw) + bf_lo(qw1)) * 0.08838834764831845f, (bf_hi(qw) + bf_hi(qw1)) * 0.08838834764831845f};
        }
    }
    __syncthreads();
    if (wave < 4) {
        const int key = lane + 64 * wave;
        float s[8];
#pragma unroll
        for (int t = 0; t < 8; ++t) s[t] = 0.f;
        const f32x4* kp = (const f32x4*)(mk + (((size_t)b * 256 + key) * 4 + h) * 128);
#pragma unroll 8
        for (int d4 = 0; d4 < 32; ++d4) {
            const f32x4 k4 = kp[d4];
#pragma unroll
            for (int t = 0; t < 8; ++t) { const f32x4 q4 = *(const LAS f32x4*)(qs + t * 128 + 4 * d4); s[t] += (k4[0] * q4[0] + k4[1] * q4[1]) + (k4[2] * q4[2] + k4[3] * q4[3]); }
        }
#pragma unroll
        for (int t = 0; t < 8; ++t) {
            const float m = wave_max(s[t]); const float p = __expf(s[t] - m); const float l = wave_sum(p);
            pT[key * 8 + t] = p;
            if (lane == 0) { ml[(wave * 8 + t) * 2] = m; ml[(wave * 8 + t) * 2 + 1] = l; }
        }
        __builtin_amdgcn_wave_barrier();
        asm volatile("s_waitcnt lgkmcnt(0)" ::: "memory");
        f32x2 o[8];
#pragma unroll
        for (int t = 0; t < 8; ++t) o[t] = (f32x2){0.f, 0.f};
#pragma unroll 16
        for (int kk = 0; kk < 64; ++kk) {
            const int k2 = 64 * wave + kk;
            const f32x2 v = *(const f32x2*)(mv + (((size_t)b * 256 + k2) * 4 + h) * 128 + 2 * lane);
            const f32x4 pa = *(const LAS f32x4*)(pT + k2 * 8), pb = *(const LAS f32x4*)(pT + k2 * 8 + 4);
            o[0] += pa[0] * v; o[1] += pa[1] * v; o[2] += pa[2] * v; o[3] += pa[3] * v; o[4] += pb[0] * v; o[5] += pb[1] * v; o[6] += pb[2] * v; o[7] += pb[3] * v;
        }
#pragma unroll
        for (int t = 0; t < 8; ++t) *(LAS f32x2*)(po + (wave * 8 + t) * 128 + 2 * lane) = o[t];
    }
    __syncthreads();
    if (wave < 4) {
#pragma unroll
        for (int t2 = 0; t2 < 2; ++t2) {
            const int t = wave * 2 + t2;
            float m = ml[(0 * 8 + t) * 2];
#pragma unroll
            for (int w = 1; w < 4; ++w) m = fmaxf(m, ml[(w * 8 + t) * 2]);
            float den = 0.f; f32x2 acc = {0.f, 0.f};
#pragma unroll
            for (int w = 0; w < 4; ++w) {
                const float sc = __expf(ml[(w * 8 + t) * 2] - m);
                den += sc * ml[(w * 8 + t) * 2 + 1];
                acc += sc * *(const LAS f32x2*)(po + (w * 8 + t) * 128 + 2 * lane);
            }
            const float inv = 1.0f / den;
            *(unsigned*)(xo + (tok0 + t) * 512 + h * 128 + 2 * lane) = pk2(acc[0] * inv, acc[1] * inv);
        }
    }
    __syncthreads();
}


__device__ __forceinline__ void sample_out_block(LAS unsigned char* lds, const bf16_t* A, const bf16_t* Bt, int K, bf16_t* xb, float* sspart, int blk, int tid) {
    const int wave = tid >> 6, lane = tid & 63, l15 = lane & 15, g = lane >> 4;
    const int rt = blk >> 5, cg = blk & 31, r0 = T_P + 32 * rt;
    const int kq = K >> 3;
    f32x4 acc[2][4];
#pragma unroll
    for (int ra = 0; ra < 2; ++ra)
#pragma unroll
        for (int nt = 0; nt < 4; ++nt) acc[ra][nt] = (f32x4){0.f, 0.f, 0.f, 0.f};
    {
        const bf16_t* ap = A + (size_t)(r0 + l15) * K + wave * kq + 8 * g;
        const bf16_t* bp = Bt + (size_t)(64 * cg + l15) * K + wave * kq + 8 * g;
        bf16x8 af[2][2], bf[2][4], afn[2][2], bfn[2][4];
#pragma unroll
        for (int s = 0; s < 2; ++s) {
#pragma unroll
            for (int ra = 0; ra < 2; ++ra) af[s][ra] = *(const bf16x8*)(ap + (size_t)(16 * ra) * K + 32 * s);
#pragma unroll
            for (int nt = 0; nt < 4; ++nt) bf[s][nt] = *(const bf16x8*)(bp + (size_t)(16 * nt) * K + 32 * s);
        }
        for (int k0 = 0; k0 < kq; k0 += 64) {
            const int k1 = (k0 + 64 < kq) ? k0 + 64 : k0;
#pragma unroll
            for (int s = 0; s < 2; ++s) {
#pragma unroll
                for (int ra = 0; ra < 2; ++ra) afn[s][ra] = *(const bf16x8*)(ap + (size_t)(16 * ra) * K + k1 + 32 * s);
#pragma unroll
                for (int nt = 0; nt < 4; ++nt) bfn[s][nt] = *(const bf16x8*)(bp + (size_t)(16 * nt) * K + k1 + 32 * s);
            }
#pragma unroll
            for (int s = 0; s < 2; ++s)
#pragma unroll
                for (int ra = 0; ra < 2; ++ra)
#pragma unroll
                    for (int nt = 0; nt < 4; ++nt) acc[ra][nt] = MFMA16(af[s][ra], bf[s][nt], acc[ra][nt]);
#pragma unroll
            for (int s = 0; s < 2; ++s) {
#pragma unroll
                for (int ra = 0; ra < 2; ++ra) af[s][ra] = afn[s][ra];
#pragma unroll
                for (int nt = 0; nt < 4; ++nt) bf[s][nt] = bfn[s][nt];
            }
        }
    }
    LAS f32x4* part = (LAS f32x4*)lds;
#pragma unroll
    for (int ra = 0; ra < 2; ++ra)
#pragma unroll
        for (int nt = 0; nt < 4; ++nt) part[(wave * 8 + ra * 4 + nt) * 64 + lane] = acc[ra][nt];
    __syncthreads();
    if (wave < 2) {
        const int ra = wave;
        f32x4 sum[4];
#pragma unroll
        for (int nt = 0; nt < 4; ++nt) {
            sum[nt] = part[(0 * 8 + ra * 4 + nt) * 64 + lane];
#pragma unroll
            for (int w = 1; w < 8; ++w) sum[nt] += part[(w * 8 + ra * 4 + nt) * 64 + lane];
        }
        float ss[4] = {0.f, 0.f, 0.f, 0.f};
#pragma unroll
        for (int j = 0; j < 4; ++j)
#pragma unroll
            for (int nt = 0; nt < 4; ++nt) {
                bf16_t* xp = xb + (size_t)(r0 + 16 * ra + 4 * g + j) * 2048 + 64 * cg + 16 * nt + l15;
                const bf16_t nv = f2bf(bf1(*xp) + sum[nt][j]);
                *xp = nv; const float r = bf1(nv); ss[j] += r * r;
            }
#pragma unroll
        for (int j = 0; j < 4; ++j) {
            float s = ss[j];
            s += __shfl_xor(s, 1); s += __shfl_xor(s, 2); s += __shfl_xor(s, 4); s += __shfl_xor(s, 8);
            if (l15 == 0) sspart[(size_t)(r0 + 16 * ra + 4 * g + j) * 32 + cg] = s;
        }
    }
    __syncthreads();
}

__global__ void __launch_bounds__(NTHREADS, 2) hybrid_fwd(Params P) {
    extern __shared__ __attribute__((aligned(16))) unsigned char lds_raw[];
    LAS unsigned char* lds = (LAS unsigned char*)lds_raw;
    cg::grid_group grid = cg::this_grid();
    if (threadIdx.x < 4) ((LAS unsigned*)(lds + LDS_BYTES - 16))[threadIdx.x] = 0u;
    __syncthreads();
    if (P.ph_hi - P.ph_lo > 1) (void)xcd_barrier_post((unsigned*)(P.ws + WS_BAR), (volatile LAS unsigned*)(lds + LDS_BYTES - 16));
    if (P.ph_hi < 0) grid.sync();
    const int tid0 = threadIdx.x, bid0 = blockIdx.x;
    int pc = 0; const int ph_lo = P.ph_lo, ph_hi = P.ph_hi;
    const int G = gridDim.x, NGW = G * 8;
#define PHASE_IDS int tid_l = tid0; asm volatile("" : "+v"(tid_l)); const int tid = tid_l, lane = tid & 63, wave = __builtin_amdgcn_readfirstlane(tid >> 6); \
    int bid_l = bid0; asm volatile("" : "+s"(bid_l)); const int bid = bid_l, gw = bid * 8 + wave; (void)lane; (void)gw; (void)tid;
#define OPQ64(v) asm volatile("" : "+s"(v))
#define GAS __attribute__((address_space(1)))
#if defined(__HIP_DEVICE_COMPILE__)
#define ASSUME_GLOBAL(p) do { __builtin_assume(!__builtin_amdgcn_is_shared((const void*)(p))); __builtin_assume(!__builtin_amdgcn_is_private((const void*)(p))); } while (0)
#else
#define ASSUME_GLOBAL(p) do { } while (0)
#endif
#define INP(name, idx) const float* name; { int ii_ = (idx); asm volatile("" : "+s"(ii_)); { const GAS float* g_ = (const GAS float*)P.in[ii_]; asm volatile("" : "+s"(g_)); name = (const float*)g_; } }
#define WSB(name, type, off) type* name; { GAS unsigned char* w_ = (GAS unsigned char*)P.ws; OPQ64(w_); name = (type*)(w_ + (off)); }
#define OUTP(name) float* name; { GAS float* o_ = (GAS float*)P.out; OPQ64(o_); name = (float*)o_; }
#ifndef REPMASK
#define REPMASK 0
#endif
#define REP(k) ((((REPMASK) >> (k)) & 1) ? 2 : 1)
#ifndef PHMASK
#define PHMASK 0xFFFFFFFF
#endif
#define PHS(k) (((PHMASK) >> (k)) & 1)
#define PH(k) ((((PHMASK) >> (k)) & 1) && pc >= ph_lo && pc < ph_hi)
#define GRID_SYNC() do { if (pc >= ph_lo && pc + 1 < ph_hi) { GAS unsigned char* w_ = (GAS unsigned char*)P.ws; OPQ64(w_); XcdBarrier xb_; xb_.bar = (unsigned*)(w_ + WS_BAR); xb_.x = xb_xcc_id(); xb_.st = (volatile LAS unsigned*)(lds + LDS_BYTES - 16); xcd_barrier(xb_); } ++pc; } while (0)
#define RUN_GEMM(EPI, Aptr, Bptr, Mv, Nv, Kv, Eobj, coff) do { pg8::Gemm gg{(const pg8::bf16_t*)(Aptr), (const pg8::bf16_t*)(Bptr), (Mv), (Nv), (Kv), (Kv)}; \
        pg8::StaticOrder SO; SO.init((Mv), (Nv), G, (bid + (coff)) % G); pg8::gemm_phase<EPI, pg8::StaticOrder, true, true>(lds, gg, SO, (Eobj)); } while (0)

    for (int rep_ = 0; rep_ < (PH(0) ? REP(0) : 0); ++rep_) {
                PHASE_IDS
        INP(x_prompt, 0) INP(x_sample, 1) INP(mem_prompt, 7) INP(norm_mix, 8) INP(w_in_even, 9) INP(w_out_even, 15) INP(w_in_ret, 16) INP(w_out_ret, 17)
        INP(norm_cross, 18) INP(norm_mem, 19) INP(w_xq, 20) INP(w_xk, 21) INP(w_xv, 22) INP(w_xo, 23)
        WSB(WinE, bf16_t, WS_WINE) WSB(WoutE, bf16_t, WS_WOUTE) WSB(WinR, bf16_t, WS_WINR) WSB(WoutR, bf16_t, WS_WOUTR)
        WSB(Wxq, bf16_t, WS_WXQ) WSB(Wxo, bf16_t, WS_WXO) WSB(Wxkv, bf16_t, WS_WXKV)
        WSB(X, float, WS_X) WSB(XB, bf16_t, WS_XB) WSB(SS, float, WS_SS) WSB(MEMB, bf16_t, WS_MEMB) WSB(MEMSS, float, WS_MEMSS)
        LAS float* scr = (LAS float*)(lds + wave * 16384);
        constexpr int NITEMS = 2 * (5376 + 2048 + 12288 + 4096) + 4 * 2048;
        for (int it = gw; it < NITEMS; it += NGW) {
            int r = it;
#define SEG(cnt, ...) if (r < (cnt)) { p0_transpose_item(__VA_ARGS__); continue; } r -= (cnt);
            SEG(5376, w_in_even, 2048, EIN, WinE, 0, scr, r, lane, norm_mix, 0, 0, 1.f)
            SEG(5376, w_in_even + (size_t)2048 * EIN, 2048, EIN, WinE + (size_t)EIN * 2048, 0, scr, r, lane, norm_mix + 2 * 2048, 0, 0, 1.f)
            SEG(2048, w_out_even, 2048, 2048, WoutE, 0, scr, r, lane, nullptr, 0, 0, 1.f)
            SEG(2048, w_out_even + (size_t)2048 * 2048, 2048, 2048, WoutE + (size_t)2048 * 2048, 0, scr, r, lane, nullptr, 0, 0, 1.f)
            SEG(12288, w_in_ret, 2048, RIN, WinR, 0, scr, r, lane, norm_mix + 1 * 2048, 2048, 4096, 0.0625f)
            SEG(12288, w_in_ret + (size_t)2048 * RIN, 2048, RIN, WinR + (size_t)RIN * 2048, 0, scr, r, lane, norm_mix + 3 * 2048, 2048, 4096, 0.0625f)
            SEG(4096, w_out_ret, 4096, 2048, WoutR, 0, scr, r, lane, nullptr, 0, 0, 1.f)
            SEG(4096, w_out_ret + (size_t)4096 * 2048, 4096, 2048, WoutR + (size_t)2048 * 4096, 0, scr, r, lane, nullptr, 0, 0, 1.f)
            {
                const int l = r >> 11, q = (r >> 9) & 3, rr = r & 511;
                if (q == 0) p0_transpose_item(w_xq + (size_t)l * 2048 * 512, 2048, 512, Wxq + (size_t)l * 512 * 2048, 0, scr, rr, lane, norm_cross + l * 2048, 0, 0, 1.f);
                else if (q == 1) p0_transpose_item(w_xo + (size_t)l * 512 * 2048, 512, 2048, Wxo + (size_t)l * 2048 * 512, 0, scr, rr, lane, nullptr, 0, 0, 1.f);
                else if (q == 2) p0_transpose_item(w_xk + (size_t)l * 2048 * 512, 2048, 512, Wxkv, l * 1024, scr, rr, lane, norm_mem + l * 2048, 0, 0, 1.f);
                else p0_transpose_item(w_xv + (size_t)l * 2048 * 512, 2048, 512, Wxkv, l * 1024 + 512, scr, rr, lane, norm_mem + l * 2048, 0, 0, 1.f);
            }
#undef SEG
        }
        for (int m = gw; m < T_ALL + 512; m += NGW) {
            if (m < T_P) p0_row(x_prompt + (size_t)m * 2048, nullptr, XB + (size_t)m * 2048, SS + (size_t)m * 32, lane);
            else if (m < T_ALL) p0_row(x_sample + (size_t)(m - T_P) * 2048, nullptr, XB + (size_t)m * 2048, SS + (size_t)m * 32, lane);
            else { const int mm = m - T_ALL; p0_row(mem_prompt + (size_t)mm * 2048, nullptr, MEMB + (size_t)mm * 2048, MEMSS + (size_t)mm * 32, lane); }
        }
    }
    GRID_SYNC();

#pragma unroll 1
    for (int l = 0; l < 4; ++l) {
        const int li = l >> 1;
        if ((l & 1) == 0) {
            for (int rep_ = 0; rep_ < (PH(1) ? REP(1) : 0); ++rep_) {
                PHASE_IDS
                WSB(Z, bf16_t, WS_Z) WSB(SS, float, WS_SS) WSB(VT, bf16_t, WS_VT) WSB(XB, bf16_t, WS_XB) WSB(WinE, bf16_t, WS_WINE)
                pg8::EpiZ E{Z, EIN, SS, 5, 9, 17, 21, 4, VT, T_ALL};
                RUN_GEMM(pg8::EpiZ, XB, WinE + (size_t)li * EIN * 2048, T_ALL, EIN, 2048, E, 0);
            }
            if (PH(1) && l == 0) {
                PHASE_IDS
                WSB(MEMKV, bf16_t, WS_MEMKV) WSB(MEMVT, bf16_t, WS_MEMVT) WSB(MEMSS, float, WS_MEMSS) WSB(MEMB, bf16_t, WS_MEMB) WSB(Wxkv, bf16_t, WS_WXKV) OUTP(out)
                pg8::EpiMem EM{MEMKV, MEMVT, out + OUT_MKP, out + OUT_MVP, MEMSS};
                RUN_GEMM(pg8::EpiMem, MEMB, Wxkv, 512, 4096, 2048, EM, G - (33 * 21) % G);
            }
            GRID_SYNC();
            for (int rep_ = 0; rep_ < (PH(2) ? REP(2) : 0); ++rep_) {
                PHASE_IDS
                INP(cache_win_k, 2) INP(cache_win_v, 3) INP(attn_sinks, 10) INP(w_spatial, 11) INP(b_spatial, 12) INP(norm_v_g, 13) INP(norm_v_b, 14) OUTP(out)
                WSB(Z, bf16_t, WS_Z) WSB(MIX, bf16_t, WS_MIX) WSB(VT, bf16_t, WS_VT)
                const float* sinks = attn_sinks + li * 16;
                const float* w_s = w_spatial + (size_t)li * 4 * 128 * 128; const float* b_s = b_spatial + li * 4 * 128;
                const float* lg_ = norm_v_g + li * 1024; const float* lb_ = norm_v_b + li * 1024;
                const float* ck = cache_win_k + (size_t)li * 32 * 128 * 128; const float* cv = cache_win_v + (size_t)li * 32 * 128 * 128;
                if (PHS(12)) for (int blk = bid; blk < 256; blk += G) { const int item = (G == 256) ? ((((blk & 7) * 8 + (blk >> 5)) << 2) | ((blk >> 3) & 3)) : blk;
                    gate_prompt_item(lds, Z, MIX, w_s, b_s, lg_, lb_, item, tid); }
                if (PHS(13)) {
                    if (NGW == 2048) {
                        if ((gw & 3) == 0) attn_prompt_item(Z, VT, MIX, sinks, 7680 + (gw >> 2), lane);
                        else { const int hw = (gw >> 2) * 3 + (gw & 3) - 1; for (int j = 0; j < 5; ++j) attn_prompt_item(Z, VT, MIX, sinks, j * 1536 + hw, lane); }
                    } else for (int it = gw; it < 8192; it += NGW) attn_prompt_item(Z, VT, MIX, sinks, it, lane);
                }
                LAS float* wl = (LAS float*)(lds + wave * 12288);
                if (PHS(14)) for (int it = gw; it < 2048; it += NGW) if ((it & 3) == 0) attn_sample_item(wl, Z, MIX, sinks, ck, cv, it >> 2, lane);
                if (PHS(15)) for (int it = gw; it < 2048; it += NGW) if ((it & 7) == 4) gate_sample_item(Z, MIX, out + OUT_CVS + (size_t)li * 262144, w_s, b_s, lg_, lb_, it >> 3, lane);
                const int gt = bid * NTHREADS + tid, NGT = G * NTHREADS;
                for (int idx = gt; idx < 32768; idx += NGT) {
                    const int c = idx & 127, j = (idx >> 7) & 127, b = idx >> 14;
                    const size_t tk = (size_t)b * SEQL + 3968 + j;
                    out[OUT_WKP + (size_t)li * 32768 + idx] = bf1(Z[tk * EIN + 1024 + c]);
                    out[OUT_WVP + (size_t)li * 32768 + idx] = bf1(Z[tk * EIN + 1152 + c]);
                }
                for (int idx = gt; idx < 524288; idx += NGT) {
                    const int c = idx & 127, j = (idx >> 7) & 127, b = idx >> 14;
                    float kvv, vvv;
                    if (j < 120) { kvv = ck[((size_t)b * 128 + j + 8) * 128 + c]; vvv = cv[((size_t)b * 128 + j + 8) * 128 + c]; }
                    else { const size_t tk = (size_t)T_P + b * 8 + (j - 120); kvv = bf1(Z[tk * EIN + 1024 + c]); vvv = bf1(Z[tk * EIN + 1152 + c]); }
                    out[OUT_WKS + (size_t)li * 524288 + idx] = kvv;
                    out[OUT_WVS + (size_t)li * 524288 + idx] = vvv;
                }
            }
            GRID_SYNC();
            if (PH(3)) {
                PHASE_IDS
                WSB(X, float, WS_X) WSB(XB, bf16_t, WS_XB) WSB(SS, float, WS_SS) WSB(MIX, bf16_t, WS_MIX) WSB(WoutE, bf16_t, WS_WOUTE)
                pg8::EpiRes E{XB, SS};
                for (int blk = bid; blk < 256; blk += G) sample_out_block(lds, MIX, WoutE + (size_t)li * 2048 * 2048, 2048, XB, SS, blk, tid);
                RUN_GEMM(pg8::EpiRes, MIX, WoutE + (size_t)li * 2048 * 2048, T_P, 2048, 2048, E, 0);
            }
            GRID_SYNC();
        } else {
            for (int rep_ = 0; rep_ < (PH(4) ? REP(4) : 0); ++rep_) {
                PHASE_IDS
                WSB(Z, bf16_t, WS_Z) WSB(SS, float, WS_SS) WSB(VT, bf16_t, WS_VT) WSB(XB, bf16_t, WS_XB) WSB(WinR, bf16_t, WS_WINR)
                pg8::EpiZ E{Z, RIN, SS, 32, 48, 0, 0, -1, VT, T_ALL};
                RUN_GEMM(pg8::EpiZ, XB, WinR + (size_t)li * RIN * 2048, T_P, RIN, 2048, E, 0);
            }
            GRID_SYNC();
            for (int rep_ = 0; rep_ < (PH(5) ? REP(5) : 0); ++rep_) {
                PHASE_IDS
                INP(state_ret, 4) OUTP(out) WSB(Z, bf16_t, WS_Z) WSB(OB, bf16_t, WS_O)
                const int half = G / 2;
                if (bid < half) {
                    if (PHS(16)) for (int blk = bid; blk < 128; blk += half) { const int item = (half == 128) ? ((((blk & 7) * 2 + (blk >> 6)) << 3) | ((blk >> 3) & 7)) : blk;
                        ret_prompt_item(lds, Z, OB, out + OUT_RSP + (size_t)li * 2097152, item, tid); }
                } else {
                    {
                        WSB(XBs, bf16_t, WS_XB) WSB(SSs, float, WS_SS) WSB(WinRs, bf16_t, WS_WINR) WSB(VTs, bf16_t, WS_VT) WSB(CNT, unsigned, WS_BAR)
                        pg8::EpiZ Es{Z + (size_t)T_P * RIN, RIN, SSs + (size_t)T_P * 32, 32, 48, 0, 0, -1, VTs, T_ALL};
                        pg8::Gemm gs{(const pg8::bf16_t*)(XBs + (size_t)T_P * 2048), (const pg8::bf16_t*)(WinRs + (size_t)li * RIN * 2048), 256, RIN, 2048, 2048};
                        pg8::StaticOrder SOs; SOs.init(256, RIN, G - half, bid - half); pg8::gemm_phase<pg8::EpiZ, pg8::StaticOrder, true, true>(lds, gs, SOs, Es);
                        unsigned* cw = CNT + 3600 + 64 * li;
                        const bool has_unit = (bid - half) < 48;
                        if (has_unit) { asm volatile("s_waitcnt vmcnt(0)" ::: "memory"); __builtin_amdgcn_fence(__ATOMIC_RELEASE, "agent"); asm volatile("s_waitcnt vmcnt(0)" ::: "memory"); }
                        __syncthreads();
                        if (tid == 0) {
                            if (has_unit) __hip_atomic_fetch_add(cw, 1u, __ATOMIC_RELAXED, __HIP_MEMORY_SCOPE_AGENT);
                            unsigned spins = 0;
                            while (__hip_atomic_load(cw, __ATOMIC_RELAXED, __HIP_MEMORY_SCOPE_AGENT) < 48u) { __builtin_amdgcn_s_sleep(8); if (++spins > (1u << 22)) break; }
                            __builtin_amdgcn_fence(__ATOMIC_ACQUIRE, "agent"); asm volatile("s_waitcnt vmcnt(0)" ::: "memory");
                        }
                        __syncthreads();
                    }
                    if (PHS(17)) for (int item = bid - half; item < 256; item += (G - half))
                        ret_sample_item(lds, Z, OB, state_ret + (size_t)li * 33554432, out + OUT_RSS + (size_t)li * 33554432, item, tid);
                }
            }
            GRID_SYNC();
            for (int rep_ = 0; rep_ < (PH(6) ? REP(6) : 0); ++rep_) {
                PHASE_IDS
                WSB(Z, bf16_t, WS_Z) WSB(OB, bf16_t, WS_O) WSB(MIX, bf16_t, WS_MIX)
                for (int it0 = gw; it0 < T_ALL * 8; it0 += 4 * NGW) {
                    u32x4 av[4], gv[4];
#pragma unroll
                    for (int r = 0; r < 4; ++r) {
                        int it = it0 + r * NGW; it = it < T_ALL * 8 ? it : gw;
                        const int h = it & 7; const size_t tok = it >> 3;
                        av[r] = *(const u32x4*)(OB + tok * 4096 + h * 512 + 8 * lane); gv[r] = *(const u32x4*)(Z + tok * RIN + 8192 + h * 512 + 8 * lane);
                    }
#pragma unroll
                    for (int r = 0; r < 4; ++r) {
                        const int it = it0 + r * NGW;
                        const int h = it & 7; const size_t tok = it >> 3;
                        const u32x4 a = av[r], gq = gv[r];
                        float v[8] = {bf_lo(a.x), bf_hi(a.x), bf_lo(a.y), bf_hi(a.y), bf_lo(a.z), bf_hi(a.z), bf_lo(a.w), bf_hi(a.w)};
                        float s = 0.f;
#pragma unroll
                        for (int e = 0; e < 8; ++e) s += v[e];
                        const float mean = wave_sum(s) * (1.0f / 512.0f);
                        float q = 0.f;
#pragma unroll
                        for (int e = 0; e < 8; ++e) { v[e] -= mean; q += v[e] * v[e]; }
                        const float rstd = rsqrtf(wave_sum(q) * (1.0f / 512.0f) + EPSN);
                        u32x4 w; w.x = pk2(v[0] * rstd * bf_lo(gq.x), v[1] * rstd * bf_hi(gq.x)); w.y = pk2(v[2] * rstd * bf_lo(gq.y), v[3] * rstd * bf_hi(gq.y));
                        w.z = pk2(v[4] * rstd * bf_lo(gq.z), v[5] * rstd * bf_hi(gq.z)); w.w = pk2(v[6] * rstd * bf_lo(gq.w), v[7] * rstd * bf_hi(gq.w));
                        if (it < T_ALL * 8) *(u32x4*)(MIX + tok * 4096 + h * 512 + 8 * lane) = w;
                    }
                }
            }
            GRID_SYNC();
            if (PH(7)) {
                PHASE_IDS
                WSB(X, float, WS_X) WSB(XB, bf16_t, WS_XB) WSB(SS, float, WS_SS) WSB(MIX, bf16_t, WS_MIX) WSB(WoutR, bf16_t, WS_WOUTR)
                pg8::EpiRes E{XB, SS};
                for (int blk = bid; blk < 256; blk += G) sample_out_block(lds, MIX, WoutR + (size_t)li * 2048 * 4096, 4096, XB, SS, blk, tid);
                RUN_GEMM(pg8::EpiRes, MIX, WoutR + (size_t)li * 2048 * 4096, T_P, 2048, 4096, E, 0);
            }
            GRID_SYNC();
        }
        for (int rep_ = 0; rep_ < (PH(8) ? REP(8) : 0); ++rep_) {
                PHASE_IDS
            WSB(XQ, bf16_t, WS_XQ) WSB(SS, float, WS_SS) WSB(VT, bf16_t, WS_VT) WSB(XB, bf16_t, WS_XB) WSB(Wxq, bf16_t, WS_WXQ)
            WSB(XQ1, bf16_t, WS_Z)
            for (int sk = 0; sk < 2; ++sk) {
                pg8::EpiZ E{sk ? XQ1 : XQ, 512, SS, 0, 0, 0, 0, -1, VT, T_ALL};
                pg8::Gemm gg{(const pg8::bf16_t*)(XB + sk * 1024), (const pg8::bf16_t*)(Wxq + (size_t)l * 512 * 2048 + sk * 1024), T_ALL, 512, 1024, 2048};
                pg8::StaticOrder SO; SO.init(T_ALL, 512, G, (bid + (sk ? G - 66 : 0)) % G); pg8::gemm_phase<pg8::EpiZ, pg8::StaticOrder, true, true>(lds, gg, SO, E);
            }
        }
        GRID_SYNC();
        for (int rep_ = 0; rep_ < (PH(9) ? REP(9) : 0); ++rep_) {
                PHASE_IDS
            INP(cache_mem_k, 5) INP(cache_mem_v, 6)
            WSB(XQ, bf16_t, WS_XQ) WSB(XQ1, bf16_t, WS_Z) WSB(XO, bf16_t, WS_XO) WSB(MEMKV, bf16_t, WS_MEMKV) WSB(MEMVT, bf16_t, WS_MEMVT) WSB(DUMMY, bf16_t, WS_O)
            LAS float* wl = (LAS float*)(lds + wave * 12288);
            const float* mk = cache_mem_k + (size_t)l * 32 * 256 * 512; const float* mv = cache_mem_v + (size_t)l * 32 * 256 * 512;
            const int hb = G / 2;
            if (bid >= hb) { if (PHS(19)) for (int it = bid - hb; it < 128; it += (G - hb)) xattn_sample_block(lds, XQ, XQ1, mk, mv, XO, it, tid); }
            if (PHS(18)) for (int it = gw; it < 2048; it += NGW) xattn_prompt_item(XQ, XQ1, MEMKV, MEMVT, XO, l, it, lane);
        }
        GRID_SYNC();
        if (PH(10)) {
                PHASE_IDS
            WSB(X, float, WS_X) WSB(XB, bf16_t, WS_XB) WSB(SS, float, WS_SS) WSB(XO, bf16_t, WS_XO) WSB(Wxo, bf16_t, WS_WXO)
            pg8::EpiRes E{XB, SS};
            for (int blk = bid; blk < 256; blk += G) sample_out_block(lds, XO, Wxo + (size_t)l * 2048 * 512, 512, XB, SS, blk, tid);
            RUN_GEMM(pg8::EpiRes, XO, Wxo + (size_t)l * 2048 * 512, T_P, 2048, 512, E, 0);
        }
        GRID_SYNC();
    }
    if (PH(11)) {
                PHASE_IDS
        INP(norm_final, 24) OUTP(out) WSB(X, float, WS_X) WSB(SS, float, WS_SS)
        WSB(XBf, bf16_t, WS_XB)
        for (int m = gw; m < T_ALL; m += NGW) {
            const float sp = (lane < 32) ? SS[(size_t)m * 32 + lane] : 0.f;
            const float rstd = rsqrtf(wave_sum(sp) * (1.0f / 2048.0f) + EPSN);
            const u32x2* xr = (const u32x2*)(XBf + (size_t)m * 2048) + lane; const f32x4* gr_ = (const f32x4*)norm_final + lane;
            f32x4* yr = (f32x4*)(out + OUT_YP + (size_t)m * 2048) + lane;
#pragma unroll
            for (int j = 0; j < 8; ++j) { const u32x2 w = xr[64 * j]; const f32x4 xv = {bf_lo(w.x), bf_hi(w.x), bf_lo(w.y), bf_hi(w.y)}; yr[64 * j] = xv * rstd * gr_[64 * j]; }
        }
    }
}

extern "C" void kernel_launch(void* const* d_in, const int* in_sizes, int n_in, void* d_out, int out_size, void* d_ws, size_t ws_size, hipStream_t stream) {
    static int grid = 0;
    if (grid == 0) {
        if (n_in != 25 || (size_t)out_size != OUT_TOTAL || ws_size < WS_END) {
            fprintf(stderr, "kernel_launch: unexpected shapes: n_in %d out_size %d ws %zu (need %zu)\n", n_in, out_size, ws_size, (size_t)WS_END); grid = -1; return; }
        int dev = 0, cus = 0, per_cu = 0;
        (void)hipGetDevice(&dev);
        (void)hipDeviceGetAttribute(&cus, hipDeviceAttributeMultiprocessorCount, dev);
        if (hipFuncSetAttribute((const void*)hybrid_fwd, hipFuncAttributeMaxDynamicSharedMemorySize, LDS_BYTES) != hipSuccess) { fprintf(stderr, "kernel_launch: hipFuncSetAttribute failed\n"); grid = -1; return; }
        if (hipOccupancyMaxActiveBlocksPerMultiprocessor(&per_cu, (const void*)hybrid_fwd, NTHREADS, LDS_BYTES) != hipSuccess || per_cu < 1) { fprintf(stderr, "kernel_launch: occupancy query gave %d\n", per_cu); per_cu = 1; }
        (void)hipGetLastError();
        grid = cus * 1;
        if (grid <= 0) grid = 256;
    }
    if (grid < 0) return;
    Params p{};
    for (int i = 0; i < 25; ++i) p.in[i] = (const float*)d_in[i];
    p.out = (float*)d_out; p.ws = (unsigned char*)d_ws;
    constexpr int NPHASES = 28;
#if defined(SPLIT_LAUNCHES)
    for (int ph = 0; ph < NPHASES; ++ph) {
        p.ph_lo = ph; p.ph_hi = ph + 1;
        hipLaunchKernelGGL(hybrid_fwd, dim3(grid), dim3(NTHREADS), LDS_BYTES, stream, p);
    }
#else
    p.ph_lo = 0; p.ph_hi = NPHASES;
    if (hipMemsetAsync((char*)d_ws + WS_BAR, 0, 16384, stream) != hipSuccess) { fprintf(stderr, "kernel_launch: memset of the barrier words failed\n"); return; }
    void* args[] = {&p};
    hipError_t e = hipLaunchCooperativeKernel((const void*)hybrid_fwd, dim3(grid), dim3(NTHREADS), args, LDS_BYTES, stream);
    if (e != hipSuccess) fprintf(stderr, "kernel_launch: cooperative launch failed: %s (grid %d)\n", hipGetErrorString(e), grid);
#endif
}
```

```cpp
#include <hip/hip_runtime.h>
#include <hip/hip_cooperative_groups.h>
#include <cstdio>
#include <cstdint>
namespace cg = cooperative_groups;
namespace pg8 {
#define PG8_LAS __attribute__((address_space(3)))
typedef unsigned short bf16_t;
typedef short bf16x8 __attribute__((ext_vector_type(8)));
typedef float f32x4 __attribute__((ext_vector_type(4)));
typedef unsigned u32x4 __attribute__((ext_vector_type(4)));
constexpr int BM = 256, BK = 64, HALF = 128, HTB = HALF * BK * 2  , STAGE_BYTES = 8 * HTB, NXCD = 8, WGM = 8;

__host__ __device__ __forceinline__ int lds_byte(int r, int c) { const int st = (r >> 4) * 2 + (c >> 5), rr = r & 15, cc = c & 31, ob = rr * 64 + cc * 2; return st * 1024 + (ob ^ (((ob >> 9) & 1) << 5)); }
__host__ __device__ __forceinline__ void stage_rc(int b, int& R, int& C) { const int st = b / 1024, sb = b % 1024, swz = sb ^ (((sb >> 9) & 1) << 5); R = (st >> 1) * 16 + swz / 64; C = (st & 1) * 32 + (swz % 64) / 2; }
__host__ __device__ __forceinline__ int perm32(int rho) { const int n = rho >> 4, i = rho & 15; return 8 * (i >> 2) + 4 * n + (i & 3); }

struct Unit { int pm, pn; };
struct Gemm { const bf16_t* A; const bf16_t* Bt; int M, N, K, ld; };

struct StaticOrder {
    int nM, nN, nwg, G, c;
    __host__ __device__ void init(int M, int N, int G_, int c_) { nM = M / BM; nN = N / BM; nwg = nM * nN; G = G_; c = c_; }
    __host__ __device__ bool next(int i, Unit& u) const {
        const long L = (long)i * G + c; if (L >= nwg) return false;
        int wgid = (int)L; { const int q = nwg / NXCD, r = nwg % NXCD, xcd = wgid % NXCD, off = wgid / NXCD; wgid = (xcd < r ? xcd * (q + 1) : r * (q + 1) + (xcd - r) * q) + off; }
        const int nig = WGM * nN, gid = wgid / nig, fm = gid * WGM, gsz = (nM - fm) < WGM ? (nM - fm) : WGM;
        u.pm = fm + ((wgid % nig) % gsz); u.pn = (wgid % nig) / gsz; return true;
    }
    __device__ __forceinline__ void a_ready(const Unit&) const {}
    __device__ __forceinline__ void done(const Unit&) const {}
};
typedef float f32x2c __attribute__((ext_vector_type(2)));
typedef __bf16 bf16x2c __attribute__((ext_vector_type(2)));
__device__ __forceinline__ unsigned cvt_pk_bf16(float lo, float hi) { const f32x2c f = {lo, hi}; const bf16x2c h = __builtin_convertvector(f, bf16x2c); return __builtin_bit_cast(unsigned, h); }
template <class Epi, class Sched, bool ALIGN_EPI = false, bool SP2 = false>
__device__ __forceinline__ void gemm_phase(PG8_LAS unsigned char* lds, const Gemm g, const Sched& S, const Epi& E) {
    int tid_o = threadIdx.x; asm volatile("" : "+v"(tid_o));
    const int tid = tid_o, wid = __builtin_amdgcn_readfirstlane(tid >> 6), lane = tid & 63, wr = wid >> 2, wc = wid & 3, fr = lane & 15, fq = lane >> 4;
    const int K = g.ld, nt = g.K / BK;
    unsigned voffA[2], voffB[2];
#pragma unroll
    for (int i = 0; i < 2; ++i) { int R, C; stage_rc(tid * 16 + i * 8192, R, C); const int Rb = Epi::PERM ? ((R & ~31) + perm32(R & 31)) : R;
        voffA[i] = (unsigned)(R * K + C) * 2u; voffB[i] = (unsigned)(Rb * K + C) * 2u; }
    const size_t kstep = (size_t)(BK * 2);
    const size_t hstep = (size_t)HALF * K * 2;
    const size_t tstep = 2 * hstep;
    const unsigned ldsw = (unsigned)wid * 1024u;
    const int aoff = lds_byte(wr * 64 + fr, fq * 8), boff = lds_byte(wc * 32 + fr, fq * 8);
#define PG8_SA(b, h) (((b) * 2 + (h)) * HTB)
#define PG8_SB(b, h) ((4 + (b) * 2 + (h)) * HTB)
#define PG8_STAGE(bufoff, gbase, voff) do { _Pragma("unroll") for (int _i = 0; _i < 2; ++_i) \
        __builtin_amdgcn_global_load_lds((const unsigned*)((const char*)(gbase) + (voff)[_i]), (PG8_LAS unsigned*)(lds + (bufoff) + ldsw + _i * 8192), 16, 0, 0); } while (0)
#define PG8_LDA(dst, b, h) do { _Pragma("unroll") for (int m = 0; m < 4; ++m) _Pragma("unroll") for (int k = 0; k < 2; ++k) dst[m][k] = *(const PG8_LAS bf16x8*)(lds + PG8_SA(b, h) + aoff + m * 2048 + k * 1024); } while (0)
#define PG8_LDB(dst, b, h) do { _Pragma("unroll") for (int n = 0; n < 2; ++n) _Pragma("unroll") for (int k = 0; k < 2; ++k) dst[n][k] = *(const PG8_LAS bf16x8*)(lds + PG8_SB(b, h) + boff + n * 2048 + k * 1024); } while (0)
#define PG8_MMA(ai, bj, At, Bt) do { __builtin_amdgcn_s_setprio(1); _Pragma("unroll") for (int m = 0; m < 4; ++m) _Pragma("unroll") for (int n = 0; n < 2; ++n) _Pragma("unroll") for (int k = 0; k < 2; ++k) \
        acc[ai][bj][m][n] = __builtin_amdgcn_mfma_f32_16x16x32_bf16(Bt[n][k], At[m][k], acc[ai][bj][m][n], 0, 0, 0); __builtin_amdgcn_s_setprio(0); } while (0)
#define PG8_WAIT_V(n) asm volatile("s_waitcnt vmcnt(" #n ")" ::: "memory")
#define PG8_WAIT_L(n) asm volatile("s_waitcnt lgkmcnt(" #n ")" ::: "memory")
#define PG8_BAR __builtin_amdgcn_s_barrier()
#define PG8_SCHED __builtin_amdgcn_sched_barrier(0)
    Unit cur, nxt; int ui = 0;
    if (!S.next(0, cur)) return;
    f32x4 acc[2][2][4][2];
#pragma unroll
    for (int a = 0; a < 2; ++a)
#pragma unroll
        for (int b = 0; b < 2; ++b)
#pragma unroll
            for (int m = 0; m < 4; ++m)
#pragma unroll
                for (int n = 0; n < 2; ++n) acc[a][b][m][n] = (f32x4){0.f, 0.f, 0.f, 0.f};
    bf16x8 At[4][2], B0[2][2], B1[2][2];
    const char* cA = (const char*)g.A + (size_t)cur.pm * tstep; const char* cB = (const char*)g.Bt + (size_t)cur.pn * tstep;
    S.a_ready(cur);
    if constexpr (SP2) {
        PG8_STAGE(PG8_SB(0, 0), cB, voffB); PG8_STAGE(PG8_SB(0, 1), cB + hstep, voffB); PG8_STAGE(PG8_SA(0, 0), cA, voffA); PG8_STAGE(PG8_SA(0, 1), cA + hstep, voffA);
        if (wr == 1) PG8_BAR;
        PG8_WAIT_V(2); PG8_BAR;
        PG8_STAGE(PG8_SB(1, 0), cB + kstep, voffB); PG8_STAGE(PG8_SA(1, 0), cA + kstep, voffA); PG8_STAGE(PG8_SB(1, 1), cB + hstep + kstep, voffB);
        PG8_WAIT_V(6); PG8_BAR;
    } else {
        PG8_STAGE(PG8_SB(0, 0), cB, voffB); PG8_STAGE(PG8_SA(0, 0), cA, voffA); PG8_STAGE(PG8_SB(0, 1), cB + hstep, voffB); PG8_STAGE(PG8_SA(0, 1), cA + hstep, voffA);
        if (wr == 1) PG8_BAR;
        PG8_WAIT_V(4); PG8_BAR;
        PG8_STAGE(PG8_SB(1, 0), cB + kstep, voffB); PG8_STAGE(PG8_SA(1, 0), cA + kstep, voffA); PG8_STAGE(PG8_SB(1, 1), cB + hstep + kstep, voffB);
        PG8_WAIT_V(6); PG8_BAR;
    }
    for (;;) {
        const bool has_next = S.next(ui + 1, nxt);
        const char* nA = has_next ? (const char*)g.A + (size_t)nxt.pm * tstep : cA; const char* nB = has_next ? (const char*)g.Bt + (size_t)nxt.pn * tstep : cB;
        for (int t = 0; t < nt; t += 2) {
            const bool last = (t == nt - 2);
            const char* a1 = cA + (size_t)(t + 1) * kstep;
            const char* a2 = last ? nA : cA + (size_t)(t + 2) * kstep; const char* b2 = last ? nB : cB + (size_t)(t + 2) * kstep;
            const char* a3 = a2 + kstep; const char* b3 = b2 + kstep;
            if (last && has_next) S.a_ready(nxt);
            if constexpr (SP2) {
            PG8_LDB(B0, 0, 0); PG8_LDB(B1, 0, 1); PG8_SCHED; PG8_LDA(At, 0, 0); PG8_STAGE(PG8_SA(1, 1), a1 + hstep, voffA);
            PG8_WAIT_V(8); PG8_WAIT_L(0); PG8_BAR; PG8_MMA(0, 0, At, B0); PG8_MMA(0, 1, At, B1); PG8_BAR; PG8_SCHED;
            PG8_LDA(At, 0, 1); PG8_STAGE(PG8_SB(0, 0), b2, voffB); PG8_STAGE(PG8_SB(0, 1), b2 + hstep, voffB); PG8_STAGE(PG8_SA(0, 0), a2, voffA);
            PG8_WAIT_V(8); PG8_WAIT_L(0); PG8_BAR; PG8_MMA(1, 0, At, B0); PG8_MMA(1, 1, At, B1); PG8_BAR; PG8_SCHED;
            PG8_LDB(B0, 1, 0); PG8_LDB(B1, 1, 1); PG8_SCHED; PG8_LDA(At, 1, 0); PG8_STAGE(PG8_SA(0, 1), a2 + hstep, voffA);
            PG8_WAIT_V(8); PG8_WAIT_L(0); PG8_BAR; PG8_MMA(0, 0, At, B0); PG8_MMA(0, 1, At, B1); PG8_BAR; PG8_SCHED;
            PG8_LDA(At, 1, 1); PG8_STAGE(PG8_SB(1, 0), b3, voffB); PG8_STAGE(PG8_SB(1, 1), b3 + hstep, voffB); PG8_STAGE(PG8_SA(1, 0), a3, voffA);
            PG8_WAIT_V(8); PG8_WAIT_L(0); PG8_BAR; PG8_MMA(1, 0, At, B0); PG8_MMA(1, 1, At, B1); PG8_BAR; PG8_SCHED;
            } else {
            PG8_LDB(B0, 0, 0); PG8_SCHED; PG8_LDA(At, 0, 0); PG8_STAGE(PG8_SA(1, 1), a1 + hstep, voffA);
            PG8_WAIT_L(8); PG8_BAR; PG8_WAIT_L(0); PG8_MMA(0, 0, At, B0); PG8_BAR; PG8_SCHED;
            PG8_LDB(B1, 0, 1); PG8_STAGE(PG8_SB(0, 0), b2, voffB);
            PG8_BAR; PG8_WAIT_L(0); PG8_MMA(0, 1, At, B1); PG8_BAR;
            PG8_LDA(At, 0, 1); PG8_STAGE(PG8_SA(0, 0), a2, voffA);
            PG8_BAR; PG8_WAIT_L(0); PG8_MMA(1, 0, At, B0); PG8_BAR; PG8_SCHED;
            PG8_STAGE(PG8_SB(0, 1), b2 + hstep, voffB);
            PG8_WAIT_V(6); PG8_BAR; PG8_MMA(1, 1, At, B1); PG8_BAR;
            PG8_LDB(B0, 1, 0); PG8_SCHED; PG8_LDA(At, 1, 0); PG8_STAGE(PG8_SA(0, 1), a2 + hstep, voffA);
            PG8_WAIT_L(8); PG8_BAR; PG8_WAIT_L(0); PG8_MMA(0, 0, At, B0); PG8_BAR; PG8_SCHED;
            PG8_LDB(B1, 1, 1); PG8_STAGE(PG8_SB(1, 0), b3, voffB);
            PG8_BAR; PG8_WAIT_L(0); PG8_MMA(0, 1, At, B1); PG8_BAR;
            PG8_LDA(At, 1, 1); PG8_STAGE(PG8_SA(1, 0), a3, voffA);
            PG8_BAR; PG8_WAIT_L(0); PG8_MMA(1, 0, At, B0); PG8_BAR; PG8_SCHED;
            PG8_STAGE(PG8_SB(1, 1), b3 + hstep, voffB);
            PG8_WAIT_V(6); PG8_BAR; PG8_MMA(1, 1, At, B1); PG8_BAR;
            }
        }
        if constexpr (ALIGN_EPI) { if (wr == 0) PG8_BAR; }
        if constexpr (!Epi::AFTER_DRAIN) { E(acc, cur, wr, wc, fr, fq); S.done(cur); }
        if (!has_next) break;
#pragma unroll
        for (int a = 0; a < 2; ++a)
#pragma unroll
            for (int b = 0; b < 2; ++b)
#pragma unroll
                for (int m = 0; m < 4; ++m)
#pragma unroll
                    for (int n = 0; n < 2; ++n) acc[a][b][m][n] = (f32x4){0.f, 0.f, 0.f, 0.f};
        cur = nxt; cA = nA; cB = nB; ++ui;
        if constexpr (ALIGN_EPI) { if (wr == 1) PG8_BAR; }
    }
    PG8_WAIT_V(0);
    if constexpr (!ALIGN_EPI) { if (wr == 0) PG8_BAR; }
    PG8_BAR;
    if constexpr (Epi::AFTER_DRAIN) { E.fused(acc, cur, wr, wc, fr, fq, lds, wid, lane); S.done(cur); }
#undef PG8_SA
#undef PG8_SB
#undef PG8_STAGE
#undef PG8_LDA
#undef PG8_LDB
#undef PG8_MMA
#undef PG8_WAIT_V
#undef PG8_WAIT_L
#undef PG8_BAR
#undef PG8_SCHED
}
}

#define LAS __attribute__((address_space(3)))
typedef unsigned short bf16_t;
typedef short bf16x8 __attribute__((ext_vector_type(8)));
typedef short s16x4 __attribute__((ext_vector_type(4)));
typedef float f32x4 __attribute__((ext_vector_type(4)));
typedef float f32x2 __attribute__((ext_vector_type(2)));
typedef unsigned u32x4 __attribute__((ext_vector_type(4)));
typedef unsigned u32x2 __attribute__((ext_vector_type(2)));

constexpr int T_P = 8192, T_ALL = 8448, SEQL = 4096;
constexpr int EIN = 5376, RIN = 12288;
constexpr float EPSN = 1e-6f;
constexpr size_t WS_WINE = 0;
constexpr size_t WS_WOUTE = WS_WINE + 2ull * EIN * 2048 * 2;
constexpr size_t WS_WINR = WS_WOUTE + 2ull * 2048 * 2048 * 2;
constexpr size_t WS_WOUTR = WS_WINR + 2ull * RIN * 2048 * 2;
constexpr size_t WS_WXQ = WS_WOUTR + 2ull * 2048 * 4096 * 2;
constexpr size_t WS_WXO = WS_WXQ + 4ull * 512 * 2048 * 2;
constexpr size_t WS_WXKV = WS_WXO + 4ull * 2048 * 512 * 2;
constexpr size_t WS_X = WS_WXKV + 4096ull * 2048 * 2;
constexpr size_t WS_XB = WS_X + (size_t)T_ALL * 2048 * 4;
constexpr size_t WS_SS = WS_XB + (size_t)T_ALL * 2048 * 2;
constexpr size_t WS_Z = WS_SS + (size_t)T_ALL * 32 * 4;
constexpr size_t WS_MIX = WS_Z + (size_t)T_ALL * RIN * 2;
constexpr size_t WS_O = WS_MIX + (size_t)T_ALL * 4096 * 2;
constexpr size_t WS_VT = WS_O + (size_t)T_ALL * 4096 * 2;
constexpr size_t WS_MEMB = WS_VT + 128ull * T_ALL * 2;
constexpr size_t WS_MEMSS = WS_MEMB + 512ull * 2048 * 2;
constexpr size_t WS_MEMKV = WS_MEMSS + 512ull * 32 * 4;
constexpr size_t WS_MEMVT = WS_MEMKV + 512ull * 4096 * 2;
constexpr size_t WS_XQ = WS_MEMVT + 4ull * 2 * 512 * 256 * 2;
constexpr size_t WS_XO = WS_XQ + (size_t)T_ALL * 512 * 2;
constexpr size_t WS_BAR = WS_XO + (size_t)T_ALL * 512 * 2;
constexpr size_t WS_END = WS_BAR + 16384;

constexpr size_t OUT_YP = 0, OUT_WKP = 17301504, OUT_WVP = 17367040, OUT_RSP = 17432576, OUT_MKP = 21626880, OUT_MVP = 22675456,
                 OUT_WKS = 23724032, OUT_WVS = 24772608, OUT_RSS = 25821184, OUT_CVS = 92930048, OUT_TOTAL = 93454336;

constexpr int LDS_BYTES = 147456;
constexpr int NTHREADS = 512;

struct Params { const float* in[25]; float* out; unsigned char* ws; int ph_lo, ph_hi; };

#define MFMA16(a, b, c) __builtin_amdgcn_mfma_f32_16x16x32_bf16((a), (b), (c), 0, 0, 0)

__device__ __forceinline__ float bf_lo(unsigned w) { return __uint_as_float(w << 16); }
__device__ __forceinline__ float bf_hi(unsigned w) { return __uint_as_float(w & 0xffff0000u); }
__device__ __forceinline__ float bf1(bf16_t h) { return __uint_as_float((unsigned)h << 16); }
__device__ __forceinline__ unsigned pk2(float lo, float hi) { return pg8::cvt_pk_bf16(lo, hi); }
__device__ __forceinline__ bf16_t f2bf(float f) { return (bf16_t)(pk2(f, 0.f) & 0xffffu); }
__device__ __forceinline__ float silu_f(float x) { return x * __builtin_amdgcn_rcpf(1.0f + __expf(-x)); }
__device__ __forceinline__ float wave_sum(float v) {
#pragma unroll
    for (int o = 1; o < 64; o <<= 1) v += __shfl_xor(v, o);
    return v;
}
__device__ __forceinline__ float wave_max(float v) {
#pragma unroll
    for (int o = 1; o < 64; o <<= 1) v = fmaxf(v, __shfl_xor(v, o));
    return v;
}
__device__ __forceinline__ bf16x8 as_bf16x8(u32x4 w) { return __builtin_bit_cast(bf16x8, w); }
__device__ __forceinline__ bf16x8 tr_read8(LAS unsigned char* p0, LAS unsigned char* p1) {
    const s16x4 a = __builtin_amdgcn_ds_read_tr16_b64_v4i16((LAS s16x4*)p0);
    const s16x4 b = __builtin_amdgcn_ds_read_tr16_b64_v4i16((LAS s16x4*)p1);
    return (bf16x8){a[0], a[1], a[2], a[3], b[0], b[1], b[2], b[3]};
}

namespace pg8 {
__device__ __forceinline__ void row_rstd(const float* sspart, int rowbase, int wr, int fr, int fq, float (&rs)[2][4]) {
#pragma unroll
    for (int ai = 0; ai < 2; ++ai)
#pragma unroll
        for (int m = 0; m < 4; ++m) {
            const int row = rowbase + ai * HALF + wr * 64 + m * 16 + fr;
            const f32x4* sp = (const f32x4*)(sspart + (size_t)row * 32 + 8 * fq);
            const f32x4 a = sp[0], b = sp[1];
            float s = (a[0] + a[1]) + (a[2] + a[3]) + (b[0] + b[1]) + (b[2] + b[3]);
            s += __shfl_xor(s, 16); s += __shfl_xor(s, 32);
            rs[ai][m] = rsqrtf(s * (1.0f / 2048.0f) + 1e-6f);
        }
}
struct EpiZ {
    static constexpr bool PERM = true, AFTER_DRAIN = false;
    bf16_t* O; int ldc; const float* sspart; int s1lo, s1hi, s2lo, s2hi; int vt_pn; bf16_t* vt; int vt_ld;
    __device__ __forceinline__ void operator()(const f32x4 (&acc)[2][2][4][2], const Unit& u, int wr, int wc, int fr, int fq) const {
        float rs[2][4]; row_rstd(sspart, u.pm * BM, wr, fr, fq, rs);
        const bool act = (u.pn >= s1lo && u.pn < s1hi) || (u.pn >= s2lo && u.pn < s2hi);
        const int row0 = u.pm * BM + wr * 64 + fr, col0 = u.pn * BM + wc * 32 + 8 * fq;
#pragma unroll
        for (int ai = 0; ai < 2; ++ai)
#pragma unroll
            for (int m = 0; m < 4; ++m) {
                const int row = row0 + ai * HALF + m * 16; bf16_t* rowp = O + (size_t)row * ldc + col0; const float r = rs[ai][m];
#pragma unroll
                for (int bj = 0; bj < 2; ++bj) {
                    f32x4 v0 = acc[ai][bj][m][0] * r, v1 = acc[ai][bj][m][1] * r;
                    if (act) {
#pragma unroll
                        for (int e = 0; e < 4; ++e) { v0[e] = ::silu_f(v0[e]); v1[e] = ::silu_f(v1[e]); }
                    }
                    u32x4 w; w.x = cvt_pk_bf16(v0[0], v0[1]); w.y = cvt_pk_bf16(v0[2], v0[3]); w.z = cvt_pk_bf16(v1[0], v1[1]); w.w = cvt_pk_bf16(v1[2], v1[3]);
                    *(u32x4*)(rowp + bj * HALF) = w;
                    if (bj == 1 && u.pn == vt_pn) {
                        bf16_t* vp = vt + (size_t)(wc * 32 + 8 * fq) * vt_ld + row;
                        vp[0] = (bf16_t)(w.x & 0xffffu); vp[(size_t)vt_ld] = (bf16_t)(w.x >> 16);
                        vp[(size_t)2 * vt_ld] = (bf16_t)(w.y & 0xffffu); vp[(size_t)3 * vt_ld] = (bf16_t)(w.y >> 16);
                        vp[(size_t)4 * vt_ld] = (bf16_t)(w.z & 0xffffu); vp[(size_t)5 * vt_ld] = (bf16_t)(w.z >> 16);
                        vp[(size_t)6 * vt_ld] = (bf16_t)(w.w & 0xffffu); vp[(size_t)7 * vt_ld] = (bf16_t)(w.w >> 16);
                    }
                }
            }
    }
};
struct EpiMem {
    static constexpr bool PERM = true, AFTER_DRAIN = false;
    bf16_t* kv; bf16_t* vtr; float* outk; float* outv; const float* sspart;
    __device__ __forceinline__ void operator()(const f32x4 (&acc)[2][2][4][2], const Unit& u, int wr, int wc, int fr, int fq) const {
        float rs[2][4]; row_rstd(sspart, u.pm * BM, wr, fr, fq, rs);
        const int row0 = u.pm * BM + wr * 64 + fr, col0 = u.pn * BM + wc * 32 + 8 * fq;
#pragma unroll
        for (int ai = 0; ai < 2; ++ai)
#pragma unroll
            for (int m = 0; m < 4; ++m) {
                const int row = row0 + ai * HALF + m * 16; const float r = rs[ai][m]; const int b = row >> 8, mm = row & 255;
#pragma unroll
                for (int bj = 0; bj < 2; ++bj) {
                    const int c = col0 + bj * HALF, l = c >> 10, wcol = c & 1023;
                    const f32x4 v0 = acc[ai][bj][m][0] * r, v1 = acc[ai][bj][m][1] * r;
                    u32x4 w; w.x = cvt_pk_bf16(v0[0], v0[1]); w.y = cvt_pk_bf16(v0[2], v0[3]); w.z = cvt_pk_bf16(v1[0], v1[1]); w.w = cvt_pk_bf16(v1[2], v1[3]);
                    *(u32x4*)(kv + (size_t)row * 4096 + c) = w;
                    float* op = (wcol < 512 ? outk : outv) + ((size_t)(l * 512 + row)) * 512 + (wcol & 511);
                    *(f32x4*)op = v0; *(f32x4*)(op + 4) = v1;
                    if (wcol >= 512) {
                        bf16_t* vp = vtr + ((size_t)((l * 2 + b) * 512 + (wcol - 512))) * 256 + mm;
                        vp[0] = (bf16_t)(w.x & 0xffffu); vp[256] = (bf16_t)(w.x >> 16); vp[512] = (bf16_t)(w.y & 0xffffu); vp[768] = (bf16_t)(w.y >> 16);
                        vp[1024] = (bf16_t)(w.z & 0xffffu); vp[1280] = (bf16_t)(w.z >> 16); vp[1536] = (bf16_t)(w.w & 0xffffu); vp[1792] = (bf16_t)(w.w >> 16);
                    }
                }
            }
    }
};
struct EpiRes {
    static constexpr bool PERM = false, AFTER_DRAIN = false;
    bf16_t* xb; float* sspart;
    __device__ __forceinline__ void operator()(const f32x4 (&acc)[2][2][4][2], const Unit& u, int wr, int wc, int fr, int fq) const {
        const int row0 = u.pm * BM + wr * 64 + fr, col0 = u.pn * BM + wc * 32 + 4 * fq;
#pragma unroll
        for (int half_ = 0; half_ < 2; ++half_) {
            u32x2 old[4][4];
#pragma unroll
            for (int g4 = 0; g4 < 4; ++g4) {
                const size_t off = (size_t)(row0 + half_ * HALF + g4 * 16) * 2048 + col0;
#pragma unroll
                for (int q = 0; q < 4; ++q) old[g4][q] = *(const u32x2*)(xb + off + (q >> 1) * HALF + (q & 1) * 16);
            }
#pragma unroll
            for (int g4 = 0; g4 < 4; ++g4) {
                const int ai = half_, m = g4;
                const int row = row0 + ai * HALF + m * 16; const size_t off = (size_t)row * 2048 + col0; float ss = 0.f;
#pragma unroll
                for (int q = 0; q < 4; ++q) {
                    const int bj = q >> 1, n = q & 1;
                    const f32x4 a = acc[ai][bj][m][n]; const u32x2 o = old[g4][q];
                    u32x2 w; w.x = cvt_pk_bf16(__uint_as_float(o.x << 16) + a[0], __uint_as_float(o.x & 0xffff0000u) + a[1]);
                    w.y = cvt_pk_bf16(__uint_as_float(o.y << 16) + a[2], __uint_as_float(o.y & 0xffff0000u) + a[3]);
                    *(u32x2*)(xb + off + bj * HALF + n * 16) = w;
                    const float r0 = __uint_as_float(w.x << 16), r1 = __uint_as_float(w.x & 0xffff0000u), r2 = __uint_as_float(w.y << 16), r3 = __uint_as_float(w.y & 0xffff0000u);
                    ss += (r0 * r0 + r1 * r1) + (r2 * r2 + r3 * r3);
                }
                ss += __shfl_xor(ss, 16); ss += __shfl_xor(ss, 32);
                if (fq == 0) sspart[(size_t)row * 32 + u.pn * 4 + wc] = ss;
            }
        }
    }
};
}

namespace pg8 {
struct OneRound {
    StaticOrder S; int rnd;
    __device__ bool next(int i, Unit& u) const { return i == 0 && S.next(rnd, u); }
    __device__ __forceinline__ void a_ready(const Unit&) const {}
    __device__ __forceinline__ void done(const Unit&) const {}
};
}
__device__ __forceinline__ void p0_transpose_item(const float* W, int K, int N, bf16_t* WT, int row_off, LAS float* scr, int item, int lane,
                                                  const float* gain, int sc_lo, int sc_hi, float sc) {
    const int nblk = N / 32, kb = item / nblk, nb = item % nblk, k0 = 64 * kb, n0 = 32 * nb;
    f32x4 wv[8];
#pragma unroll
    for (int i = 0; i < 8; ++i) wv[i] = *(const f32x4*)(W + (size_t)(k0 + (lane >> 3) + 8 * i) * N + n0 + 4 * (lane & 7));
#pragma unroll
    for (int i = 0; i < 8; ++i) {
        const int kk = (lane >> 3) + 8 * i;
        const float gm = gain ? gain[k0 + kk] : 1.0f;
        LAS float* sp = scr + kk * 33 + 4 * (lane & 7);
        sp[0] = wv[i][0] * gm; sp[1] = wv[i][1] * gm; sp[2] = wv[i][2] * gm; sp[3] = wv[i][3] * gm;
    }
    asm volatile("s_waitcnt lgkmcnt(0)" ::: "memory");
    const int c = lane & 7;
#pragma unroll
    for (int j = 0; j < 4; ++j) {
        const int n = (lane >> 3) + 8 * j; const LAS float* s = scr + (8 * c) * 33 + n;
        const float mlt = (n0 + n >= sc_lo && n0 + n < sc_hi) ? sc : 1.0f;
        u32x4 o; o.x = pk2(s[0 * 33] * mlt, s[1 * 33] * mlt); o.y = pk2(s[2 * 33] * mlt, s[3 * 33] * mlt);
        o.z = pk2(s[4 * 33] * mlt, s[5 * 33] * mlt); o.w = pk2(s[6 * 33] * mlt, s[7 * 33] * mlt);
        *(u32x4*)(WT + (size_t)(row_off + n0 + n) * K + k0 + 8 * c) = o;
    }
    asm volatile("s_waitcnt lgkmcnt(0)" ::: "memory");
}
__device__ __forceinline__ void p0_row(const float* src, float* x32, bf16_t* xb, float* ssp, int lane) {
    const f32x4* xr = (const f32x4*)src + lane;
    f32x4 v[8]; float s = 0.f;
#pragma unroll
    for (int j = 0; j < 8; ++j) { v[j] = xr[64 * j]; s += (v[j][0] * v[j][0] + v[j][1] * v[j][1]) + (v[j][2] * v[j][2] + v[j][3] * v[j][3]); }
    s = wave_sum(s);
#pragma unroll
    for (int j = 0; j < 8; ++j) {
        if (x32) ((f32x4*)x32)[lane + 64 * j] = v[j];
        u32x2 w; w.x = pk2(v[j][0], v[j][1]); w.y = pk2(v[j][2], v[j][3]);
        ((u32x2*)xb)[lane + 64 * j] = w;
    }
    if (lane < 32) ssp[lane] = (lane == 0) ? s : 0.f;
}

__device__ __forceinline__ void attn_prompt_item(const bf16_t* z, const bf16_t* vt, bf16_t* mix, const float* sinks, int it, int lane) {
    const int h = it & 15, qt = it >> 4, b = qt >> 8, s0 = (qt & 255) << 4, kv = h >> 3;
    const int l15 = lane & 15, g = lane >> 4;
    const size_t tokq = (size_t)b * SEQL + s0 + l15;
    const bf16_t* qp = z + tokq * EIN + h * 64 + 8 * g;
    const bf16x8 qf0 = *(const bf16x8*)qp, qf1 = *(const bf16x8*)(qp + 32);
    const float slope = exp2f(-0.5f * (float)(h + 1));
    const float sink = sinks[h];
    f32x4 sc[9];
    float mx = -1e30f;
#pragma unroll
    for (int kt = 0; kt < 9; ++kt) {
        const int p0 = s0 - 128 + 16 * kt;
        const int key = p0 + l15, keyc = key < 0 ? 0 : key;
        const bf16_t* kp = z + ((size_t)b * SEQL + keyc) * EIN + 1024 + kv * 64 + 8 * g;
        const bf16x8 k0 = *(const bf16x8*)kp, k1 = *(const bf16x8*)(kp + 32);
        f32x4 a = {0.f, 0.f, 0.f, 0.f};
        a = MFMA16(k0, qf0, a); a = MFMA16(k1, qf1, a);
#pragma unroll
        for (int j = 0; j < 4; ++j) {
            const int kpos = p0 + 4 * g + j, dist = s0 + l15 - kpos;
            const bool valid = (dist >= 0) && (dist < 128) && (kpos >= 0);
            const float v = valid ? a[j] * 0.125f - slope * (float)dist : -1e30f;
            sc[kt][j] = v; mx = fmaxf(mx, v);
        }
    }
    s16x4 vq[5][4][2];
#pragma unroll
    for (int u = 0; u < 5; ++u) {
        int pos0 = s0 - 128 + 32 * u + 4 * g, pos1 = pos0 + 16;
        pos0 = pos0 < 0 ? 0 : pos0; pos1 = pos1 < 0 ? 0 : pos1;
#pragma unroll
        for (int mi = 0; mi < 4; ++mi) {
            const bf16_t* vp = vt + (size_t)(kv * 64 + mi * 16 + l15) * T_ALL + (size_t)b * SEQL;
            vq[u][mi][0] = *(const s16x4*)(vp + pos0); vq[u][mi][1] = *(const s16x4*)(vp + pos1);
        }
    }
    mx = fmaxf(mx, __shfl_xor(mx, 16)); mx = fmaxf(mx, __shfl_xor(mx, 32)); mx = fmaxf(mx, sink);
    float sum = 0.f;
#pragma unroll
    for (int kt = 0; kt < 9; ++kt)
#pragma unroll
        for (int j = 0; j < 4; ++j) { const float p = __expf(sc[kt][j] - mx); sc[kt][j] = p; sum += p; }
    sum += __shfl_xor(sum, 16); sum += __shfl_xor(sum, 32);
    const float inv = 1.0f / (sum + __expf(sink - mx));
    f32x4 o[4];
#pragma unroll
    for (int mi = 0; mi < 4; ++mi) o[mi] = (f32x4){0.f, 0.f, 0.f, 0.f};
#pragma unroll
    for (int u = 0; u < 5; ++u) {
        u32x4 pw; pw.x = pk2(sc[2 * u][0] * inv, sc[2 * u][1] * inv); pw.y = pk2(sc[2 * u][2] * inv, sc[2 * u][3] * inv);
        if (2 * u + 1 < 9) { pw.z = pk2(sc[(2 * u + 1) % 9][0] * inv, sc[(2 * u + 1) % 9][1] * inv); pw.w = pk2(sc[(2 * u + 1) % 9][2] * inv, sc[(2 * u + 1) % 9][3] * inv); }
        else { pw.z = 0u; pw.w = 0u; }
        const bf16x8 pb = as_bf16x8(pw);
#pragma unroll
        for (int mi = 0; mi < 4; ++mi) {
            const s16x4 v0 = vq[u][mi][0], v1 = vq[u][mi][1];
            const bf16x8 va = (bf16x8){v0[0], v0[1], v0[2], v0[3], v1[0], v1[1], v1[2], v1[3]};
            o[mi] = MFMA16(va, pb, o[mi]);
        }
    }
#pragma unroll
    for (int mi = 0; mi < 4; ++mi) {
        const int col = h * 64 + mi * 16 + 4 * g;
        const u32x2 gw = *(const u32x2*)(z + tokq * EIN + 1280 + col);
        u32x2 w; w.x = pk2(o[mi][0] * bf_lo(gw.x), o[mi][1] * bf_hi(gw.x)); w.y = pk2(o[mi][2] * bf_lo(gw.y), o[mi][3] * bf_hi(gw.y));
        *(u32x2*)(mix + tokq * 2048 + col) = w;
    }
}

__device__ __forceinline__ void attn_sample_item(LAS float* wl, const bf16_t* z, bf16_t* mix, const float* sinks, const float* ck, const float* cv, int it, int lane) {
    const int h = it & 15, b = it >> 4, kv = h >> 3;
    LAS float* qs = wl;
    LAS float* pT = wl + 512;
    const size_t tok0 = (size_t)T_P + b * 8;
#pragma unroll
    for (int t = 0; t < 8; ++t) qs[t * 64 + lane] = bf1(z[(tok0 + t) * EIN + h * 64 + lane]);
    __builtin_amdgcn_wave_barrier();
    asm volatile("s_waitcnt lgkmcnt(0)" ::: "memory");
    const float slope = exp2f(-0.5f * (float)(h + 1)), sink = sinks[h];
    float s[3][8];
#pragma unroll
    for (int ps = 0; ps < 3; ++ps) {
        const int idx = lane + 64 * ps;
#pragma unroll
        for (int t = 0; t < 8; ++t) s[ps][t] = 0.f;
        if (idx < 128) {
            const f32x4* kp = (const f32x4*)(ck + (((size_t)b * 128 + idx) * 2 + kv) * 64);
#pragma unroll 8
            for (int d4 = 0; d4 < 16; ++d4) {
                const f32x4 k4 = kp[d4];
#pragma unroll
                for (int t = 0; t < 8; ++t) { const f32x4 q4 = *(const LAS f32x4*)(qs + t * 64 + 4 * d4); s[ps][t] += (k4[0] * q4[0] + k4[1] * q4[1]) + (k4[2] * q4[2] + k4[3] * q4[3]); }
            }
        } else if (idx < 136) {
            const bf16_t* kp = z + (tok0 + (idx - 128)) * EIN + 1024 + kv * 64;
#pragma unroll 4
            for (int d4 = 0; d4 < 16; ++d4) {
                const u32x2 kw = *(const u32x2*)(kp + 4 * d4);
                const float k0 = bf_lo(kw.x), k1 = bf_hi(kw.x), k2 = bf_lo(kw.y), k3 = bf_hi(kw.y);
#pragma unroll
                for (int t = 0; t < 8; ++t) { const f32x4 q4 = *(const LAS f32x4*)(qs + t * 64 + 4 * d4); s[ps][t] += (k0 * q4[0] + k1 * q4[1]) + (k2 * q4[2] + k3 * q4[3]); }
            }
        }
#pragma unroll
        for (int t = 0; t < 8; ++t) {
            const int dist = t + 128 - idx;
            const bool valid = (idx < 136) && (dist >= 0) && (dist < 128);
            s[ps][t] = valid ? s[ps][t] * 0.125f - slope * (float)dist : -1e30f;
        }
    }
#pragma unroll
    for (int t = 0; t < 8; ++t) {
        float m = fmaxf(fmaxf(s[0][t], s[1][t]), s[2][t]); m = fmaxf(wave_max(m), sink);
        const float p0 = __expf(s[0][t] - m), p1 = __expf(s[1][t] - m), p2 = __expf(s[2][t] - m);
        const float den = wave_sum(p0 + p1 + p2) + __expf(sink - m), inv = 1.0f / den;
        pT[lane * 8 + t] = p0 * inv; pT[(lane + 64) * 8 + t] = p1 * inv; if (lane < 8) pT[(lane + 128) * 8 + t] = p2 * inv;
    }
    __builtin_amdgcn_wave_barrier();
    asm volatile("s_waitcnt lgkmcnt(0)" ::: "memory");
    float o[8];
#pragma unroll
    for (int t = 0; t < 8; ++t) o[t] = 0.f;
    for (int i0 = 0; i0 < 128; i0 += 16) {
        float vv[16];
#pragma unroll
        for (int j = 0; j < 16; ++j) vv[j] = cv[(((size_t)b * 128 + i0 + j) * 2 + kv) * 64 + lane];
#pragma unroll
        for (int j = 0; j < 16; ++j) {
        const int idx = i0 + j; const float v = vv[j];
        const f32x4 pa = *(const LAS f32x4*)(pT + idx * 8), pb = *(const LAS f32x4*)(pT + idx * 8 + 4);
        o[0] += pa[0] * v; o[1] += pa[1] * v; o[2] += pa[2] * v; o[3] += pa[3] * v; o[4] += pb[0] * v; o[5] += pb[1] * v; o[6] += pb[2] * v; o[7] += pb[3] * v;
        }
    }
#pragma unroll
    for (int idx = 128; idx < 136; ++idx) {
        const float v = bf1(z[(tok0 + (idx - 128)) * EIN + 1152 + kv * 64 + lane]);
        const f32x4 pa = *(const LAS f32x4*)(pT + idx * 8), pb = *(const LAS f32x4*)(pT + idx * 8 + 4);
        o[0] += pa[0] * v; o[1] += pa[1] * v; o[2] += pa[2] * v; o[3] += pa[3] * v; o[4] += pb[0] * v; o[5] += pb[1] * v; o[6] += pb[2] * v; o[7] += pb[3] * v;
    }
#pragma unroll
    for (int t = 0; t < 8; ++t) {
        const float ga = bf1(z[(tok0 + t) * EIN + 1280 + h * 64 + lane]);
        mix[(tok0 + t) * 2048 + h * 64 + lane] = f2bf(o[t] * ga);
    }
    __builtin_amdgcn_wave_barrier();
}

__device__ __forceinline__ void gate_prompt_item(LAS unsigned char* lds, const bf16_t* z, bf16_t* mix, const float* w_s, const float* b_s,
                                                 const float* lnv_g, const float* lnv_b, int item, int tid) {
    const int gr = item & 3, n = (item >> 2) & 31, b = item >> 7;
    const int wave = tid >> 6, lane = tid & 63, l15 = lane & 15, g = lane >> 4, q4 = l15 >> 2, p4 = lane & 3;
    const size_t tok0 = (size_t)b * SEQL + n * 128;
    LAS float* stat = (LAS float*)lds;
    LAS unsigned char* vn = lds + 1024;
#pragma unroll 2
    for (int r = 0; r < 16; ++r) {
        const int row = 16 * wave + r;
        const bf16_t* vp = z + (tok0 + row) * EIN + 3328 + lane * 16;
        const u32x4 a = *(const u32x4*)vp, c = *(const u32x4*)(vp + 8);
        float v[16] = {bf_lo(a.x), bf_hi(a.x), bf_lo(a.y), bf_hi(a.y), bf_lo(a.z), bf_hi(a.z), bf_lo(a.w), bf_hi(a.w),
                       bf_lo(c.x), bf_hi(c.x), bf_lo(c.y), bf_hi(c.y), bf_lo(c.z), bf_hi(c.z), bf_lo(c.w), bf_hi(c.w)};
        float s = 0.f;
#pragma unroll
        for (int e = 0; e < 16; ++e) s += v[e];
        const float mean = wave_sum(s) * (1.0f / 1024.0f);
        float q = 0.f;
#pragma unroll
        for (int e = 0; e < 16; ++e) { const float d = v[e] - mean; q += d * d; }
        const float rstd = rsqrtf(wave_sum(q) * (1.0f / 1024.0f) + EPSN);
        if (lane == 0) { stat[row * 2] = mean; stat[row * 2 + 1] = rstd; }
    }
    __syncthreads();
#pragma unroll
    for (int i = 0; i < 8; ++i) {
        const int idx = tid + 512 * i, row = idx >> 5, ch = idx & 31;
        const u32x4 a = *(const u32x4*)(z + (tok0 + row) * EIN + 3328 + gr * 256 + ch * 8);
        const f32x4 g0 = *(const f32x4*)(lnv_g + gr * 256 + ch * 8), g1 = *(const f32x4*)(lnv_g + gr * 256 + ch * 8 + 4);
        const f32x4 b0 = *(const f32x4*)(lnv_b + gr * 256 + ch * 8), b1 = *(const f32x4*)(lnv_b + gr * 256 + ch * 8 + 4);
        const float mean = stat[row * 2], rstd = stat[row * 2 + 1];
        u32x4 w;
        w.x = pk2((bf_lo(a.x) - mean) * rstd * g0[0] + b0[0], (bf_hi(a.x) - mean) * rstd * g0[1] + b0[1]);
        w.y = pk2((bf_lo(a.y) - mean) * rstd * g0[2] + b0[2], (bf_hi(a.y) - mean) * rstd * g0[3] + b0[3]);
        w.z = pk2((bf_lo(a.z) - mean) * rstd * g1[0] + b1[0], (bf_hi(a.z) - mean) * rstd * g1[1] + b1[1]);
        w.w = pk2((bf_lo(a.w) - mean) * rstd * g1[2] + b1[2], (bf_hi(a.w) - mean) * rstd * g1[3] + b1[3]);
        *(LAS u32x4*)(vn + row * 528 + ch * 16) = w;
    }
    __syncthreads();
    const int i = 16 * wave + l15, nks = (wave >> 1) + 1;
    bf16x8 bfr[4];
#pragma unroll
    for (int ks = 0; ks < 4; ++ks) {
        u32x4 w = {0u, 0u, 0u, 0u};
        if (ks < nks) {
            const int j0 = 32 * ks + 8 * g;
            const float* wp = w_s + ((size_t)gr * 128 + i) * 128 + j0;
            const f32x4 a = *(const f32x4*)wp, c = *(const f32x4*)(wp + 4);
            w.x = pk2(j0 + 0 <= i ? a[0] : 0.f, j0 + 1 <= i ? a[1] : 0.f); w.y = pk2(j0 + 2 <= i ? a[2] : 0.f, j0 + 3 <= i ? a[3] : 0.f);
            w.z = pk2(j0 + 4 <= i ? c[0] : 0.f, j0 + 5 <= i ? c[1] : 0.f); w.w = pk2(j0 + 6 <= i ? c[2] : 0.f, j0 + 7 <= i ? c[3] : 0.f);
        }
        bfr[ks] = as_bf16x8(w);
    }
    const float bias = b_s[gr * 128 + i];
    const size_t tok = tok0 + i;
    u32x2 uq[16], gq[16];
#pragma unroll
    for (int ct = 0; ct < 16; ++ct) { const int col = gr * 256 + 16 * ct + 4 * g; uq[ct] = *(const u32x2*)(z + tok * EIN + 2304 + col); gq[ct] = *(const u32x2*)(z + tok * EIN + 4352 + col); }
#pragma unroll
    for (int ct = 0; ct < 16; ++ct) {
        f32x4 acc = {0.f, 0.f, 0.f, 0.f};
#pragma unroll
        for (int ks = 0; ks < 4; ++ks)
            if (ks < nks) {
                LAS unsigned char* ap = vn + (32 * ks + 8 * g + q4) * 528 + (16 * ct + 4 * p4) * 2;
                const bf16x8 a = tr_read8(ap, ap + 4 * 528);
                acc = MFMA16(a, bfr[ks], acc);
            }
        const int col = gr * 256 + 16 * ct + 4 * g;
        const u32x2 uw = uq[ct], gw = gq[ct];
        u32x2 w;
        w.x = pk2(bf_lo(gw.x) * bf_lo(uw.x) * (acc[0] + bias), bf_hi(gw.x) * bf_hi(uw.x) * (acc[1] + bias));
        w.y = pk2(bf_lo(gw.y) * bf_lo(uw.y) * (acc[2] + bias), bf_hi(gw.y) * bf_hi(uw.y) * (acc[3] + bias));
        *(u32x2*)(mix + tok * 2048 + 1024 + col) = w;
    }
    __syncthreads();
}

__device__ __forceinline__ void gate_sample_item(const bf16_t* z, bf16_t* mix, float* cvs  , const float* w_s, const float* b_s,
                                                 const float* lnv_g, const float* lnv_b, int it, int lane) {
    const int cq = it & 7, b = it >> 3, gr = cq >> 1;
    const size_t tok0 = (size_t)T_P + b * 8;
    const int c = cq * 128 + 2 * lane;
    float vn0[8], vn1[8];
#pragma unroll
    for (int j = 0; j < 8; ++j) {
        const bf16_t* vp = z + (tok0 + j) * EIN + 3328 + lane * 16;
        const u32x4 a = *(const u32x4*)vp, cc = *(const u32x4*)(vp + 8);
        float v[16] = {bf_lo(a.x), bf_hi(a.x), bf_lo(a.y), bf_hi(a.y), bf_lo(a.z), bf_hi(a.z), bf_lo(a.w), bf_hi(a.w),
                       bf_lo(cc.x), bf_hi(cc.x), bf_lo(cc.y), bf_hi(cc.y), bf_lo(cc.z), bf_hi(cc.z), bf_lo(cc.w), bf_hi(cc.w)};
        float s = 0.f;
#pragma unroll
        for (int e = 0; e < 16; ++e) s += v[e];
        const float mean = wave_sum(s) * (1.0f / 1024.0f);
        float q = 0.f;
#pragma unroll
        for (int e = 0; e < 16; ++e) { const float d = v[e] - mean; q += d * d; }
        const float rstd = rsqrtf(wave_sum(q) * (1.0f / 1024.0f) + EPSN);
        const unsigned xw = *(const unsigned*)(z + (tok0 + j) * EIN + 3328 + c);
        vn0[j] = (bf_lo(xw) - mean) * rstd * lnv_g[c] + lnv_b[c];
        vn1[j] = (bf_hi(xw) - mean) * rstd * lnv_g[c + 1] + lnv_b[c + 1];
        *(f32x2*)(cvs + ((size_t)b * 8 + j) * 1024 + c) = (f32x2){vn0[j], vn1[j]};
    }
#pragma unroll
    for (int t = 0; t < 8; ++t) {
        float m0 = b_s[gr * 128 + t], m1 = m0;
#pragma unroll
        for (int j = 0; j < 8; ++j)
            if (j <= t) { const float w = w_s[((size_t)gr * 128 + t) * 128 + j]; m0 += w * vn0[j]; m1 += w * vn1[j]; }
        const unsigned uw = *(const unsigned*)(z + (tok0 + t) * EIN + 2304 + c), gw = *(const unsigned*)(z + (tok0 + t) * EIN + 4352 + c);
        *(unsigned*)(mix + (tok0 + t) * 2048 + 1024 + c) = pk2(bf_lo(gw) * bf_lo(uw) * m0, bf_hi(gw) * bf_hi(uw) * m1);
    }
}

__device__ __forceinline__ void ret_prompt_item(LAS unsigned char* lds, const bf16_t* z, bf16_t* o, float* state_out, int item, int tid) {
    const int et = item & 7, h = (item >> 3) & 7, b = item >> 6;
    const int wave = tid >> 6, lane = tid & 63, l15 = lane & 15, g = lane >> 4, q4 = l15 >> 2, p4 = lane & 3;
    const float lg = log1pf(-exp2f(-5.0f - (float)h));
    LAS unsigned char* Kn = lds;
    LAS unsigned char* Vn = lds + 67584;
    LAS unsigned char* Vd = Vn + 18432;
    LAS unsigned char* St = Vd + 18432;
    for (int idx = tid; idx < 33792 / 4; idx += NTHREADS) ((LAS unsigned*)St)[idx] = 0u;
    f32x4 accS[4][2];
#pragma unroll
    for (int e4 = 0; e4 < 4; ++e4) { accS[e4][0] = (f32x4){0.f, 0.f, 0.f, 0.f}; accS[e4][1] = (f32x4){0.f, 0.f, 0.f, 0.f}; }
    const float g128 = expf(128.0f * lg);
    const int i = 16 * wave + l15;
    const float qd = expf((float)(i + 1) * lg);
    const float lg2 = lg * 1.44269504089f;
    u32x4 kreg[8], vreg[2];
    {
        const size_t tk = (size_t)b * SEQL;
#pragma unroll
        for (int r = 0; r < 8; ++r) { const int idx = tid + 512 * r, row = idx >> 5, ch = idx & 31; kreg[r] = *(const u32x4*)(z + (tk + row) * RIN + 2048 + h * 256 + ch * 8); }
#pragma unroll
        for (int r = 0; r < 2; ++r) { const int idx = tid + 512 * r, row = idx >> 3, ch = idx & 7; vreg[r] = *(const u32x4*)(z + (tk + row) * RIN + 4096 + h * 512 + et * 64 + ch * 8); }
    }
    for (int c = 0; c < 32; ++c) {
        const size_t tok0 = (size_t)b * SEQL + c * 128;
        bf16x8 qf[8];
#pragma unroll
        for (int ks = 0; ks < 8; ++ks) qf[ks] = *(const bf16x8*)(z + (tok0 + i) * RIN + h * 256 + 32 * ks + 8 * g);
        __syncthreads();
#pragma unroll
        for (int r = 0; r < 8; ++r) { const int idx = tid + 512 * r, row = idx >> 5, ch = idx & 31; *(LAS u32x4*)(Kn + row * 528 + ch * 16) = kreg[r]; }
#pragma unroll
        for (int r = 0; r < 2; ++r) {
            const int idx = tid + 512 * r, row = idx >> 3, ch = idx & 7;
            const u32x4 v = vreg[r];
            *(LAS u32x4*)(Vn + row * 144 + ch * 16) = v;
            const float dec = __builtin_amdgcn_exp2f((float)(127 - row) * lg2);
            u32x4 w; w.x = pk2(bf_lo(v.x) * dec, bf_hi(v.x) * dec); w.y = pk2(bf_lo(v.y) * dec, bf_hi(v.y) * dec);
            w.z = pk2(bf_lo(v.z) * dec, bf_hi(v.z) * dec); w.w = pk2(bf_lo(v.w) * dec, bf_hi(v.w) * dec);
            *(LAS u32x4*)(Vd + row * 144 + ch * 16) = w;
        }
        __syncthreads();
        if (c + 1 < 32) {
            const size_t tk = tok0 + 128;
#pragma unroll
            for (int r = 0; r < 8; ++r) { const int idx = tid + 512 * r, row = idx >> 5, ch = idx & 31; kreg[r] = *(const u32x4*)(z + (tk + row) * RIN + 2048 + h * 256 + ch * 8); }
#pragma unroll
            for (int r = 0; r < 2; ++r) { const int idx = tid + 512 * r, row = idx >> 3, ch = idx & 7; vreg[r] = *(const u32x4*)(z + (tk + row) * RIN + 4096 + h * 512 + et * 64 + ch * 8); }
        }
        f32x4 ao[4];
#pragma unroll
        for (int e4 = 0; e4 < 4; ++e4) {
            f32x4 a = {0.f, 0.f, 0.f, 0.f};
#pragma unroll
            for (int ks = 0; ks < 8; ++ks) { const bf16x8 sa = *(const LAS bf16x8*)(St + (16 * e4 + l15) * 528 + (32 * ks + 8 * g) * 2); a = MFMA16(sa, qf[ks], a); }
            ao[e4] = a * qd;
        }
#pragma unroll 1
        for (int u = 0; u < 4; ++u) {
            if (2 * u <= wave) {
                f32x4 p0 = {0.f, 0.f, 0.f, 0.f}, p1 = {0.f, 0.f, 0.f, 0.f};
#pragma unroll
                for (int ks = 0; ks < 8; ++ks) { const bf16x8 ka = *(const LAS bf16x8*)(Kn + (32 * u + l15) * 528 + (32 * ks + 8 * g) * 2); p0 = MFMA16(ka, qf[ks], p0); }
                if (2 * u + 1 <= wave) {
#pragma unroll
                    for (int ks = 0; ks < 8; ++ks) { const bf16x8 ka = *(const LAS bf16x8*)(Kn + (32 * u + 16 + l15) * 528 + (32 * ks + 8 * g) * 2); p1 = MFMA16(ka, qf[ks], p1); }
                }
                float d0[4], d1[4];
#pragma unroll
                for (int jj = 0; jj < 4; ++jj) {
                    const int j0 = 32 * u + 4 * g + jj, j1 = j0 + 16;
                    d0[jj] = (i >= j0) ? p0[jj] * __builtin_amdgcn_exp2f((float)(i - j0) * lg2) : 0.f;
                    d1[jj] = (i >= j1) ? p1[jj] * __builtin_amdgcn_exp2f((float)(i - j1) * lg2) : 0.f;
                }
                u32x4 pw; pw.x = pk2(d0[0], d0[1]); pw.y = pk2(d0[2], d0[3]); pw.z = pk2(d1[0], d1[1]); pw.w = pk2(d1[2], d1[3]);
                const bf16x8 pb = as_bf16x8(pw);
#pragma unroll
                for (int e4 = 0; e4 < 4; ++e4) {
                    LAS unsigned char* ap = Vn + (32 * u + 4 * g + q4) * 144 + (16 * e4 + 4 * p4) * 2;
                    const bf16x8 va = tr_read8(ap, ap + 16 * 144);
                    ao[e4] = MFMA16(va, pb, ao[e4]);
                }
            }
        }
#pragma unroll
        for (int e4 = 0; e4 < 4; ++e4) {
            u32x2 w; w.x = pk2(ao[e4][0], ao[e4][1]); w.y = pk2(ao[e4][2], ao[e4][3]);
            *(u32x2*)(o + (tok0 + i) * 4096 + h * 512 + et * 64 + 16 * e4 + 4 * g) = w;
        }
        __syncthreads();
#pragma unroll
        for (int e4 = 0; e4 < 4; ++e4) { accS[e4][0] = accS[e4][0] * g128; accS[e4][1] = accS[e4][1] * g128; }
#pragma unroll
        for (int ks = 0; ks < 4; ++ks) {
            bf16x8 kb[2];
#pragma unroll
            for (int dt = 0; dt < 2; ++dt) { LAS unsigned char* bp = Kn + (32 * ks + 8 * g + q4) * 528 + (16 * (2 * wave + dt) + 4 * p4) * 2; kb[dt] = tr_read8(bp, bp + 4 * 528); }
#pragma unroll
            for (int e4 = 0; e4 < 4; ++e4) {
                LAS unsigned char* ap = Vd + (32 * ks + 8 * g + q4) * 144 + (16 * e4 + 4 * p4) * 2;
                const bf16x8 va = tr_read8(ap, ap + 4 * 144);
                accS[e4][0] = MFMA16(kb[0], va, accS[e4][0]); accS[e4][1] = MFMA16(kb[1], va, accS[e4][1]);
            }
        }
#pragma unroll
        for (int e4 = 0; e4 < 4; ++e4)
#pragma unroll
            for (int dt = 0; dt < 2; ++dt)
            { u32x2 w; w.x = pk2(accS[e4][dt][0], accS[e4][dt][1]); w.y = pk2(accS[e4][dt][2], accS[e4][dt][3]);
                *(LAS u32x2*)(St + (16 * e4 + l15) * 528 + (16 * (2 * wave + dt) + 4 * g) * 2) = w; }
    }
#pragma unroll
    for (int e4 = 0; e4 < 4; ++e4)
#pragma unroll
        for (int dt = 0; dt < 2; ++dt) {
#pragma unroll
            for (int jj = 0; jj < 4; ++jj) { const int d = 16 * (2 * wave + dt) + 4 * g + jj;
                state_out[((size_t)(b * 8 + h) * 256 + d) * 512 + et * 64 + 16 * e4 + l15] = accS[e4][dt][jj]; }
        }
    __syncthreads();
}

__device__ __forceinline__ void ret_sample_item(LAS unsigned char* lds, const bf16_t* z, bf16_t* o, const float* S_in, float* S_out, int item, int tid) {
    const int h = item & 7, b = item >> 3;
    const float lg = log1pf(-exp2f(-5.0f - (float)h));
    LAS float* qs = (LAS float*)lds;
    LAS float* ks = qs + 2048;
    LAS float* scs = ks + 2048;
    LAS float* red = scs + 64;
    const size_t tok0 = (size_t)T_P + b * 8;
    {
        const int t = tid >> 6, ln = tid & 63;
        const u32x2 qw = *(const u32x2*)(z + (tok0 + t) * RIN + h * 256 + 4 * ln), kw = *(const u32x2*)(z + (tok0 + t) * RIN + 2048 + h * 256 + 4 * ln);
        qs[(4 * ln + 0) * 8 + t] = bf_lo(qw.x); qs[(4 * ln + 1) * 8 + t] = bf_hi(qw.x); qs[(4 * ln + 2) * 8 + t] = bf_lo(qw.y); qs[(4 * ln + 3) * 8 + t] = bf_hi(qw.y);
        ks[(4 * ln + 0) * 8 + t] = bf_lo(kw.x); ks[(4 * ln + 1) * 8 + t] = bf_hi(kw.x); ks[(4 * ln + 2) * 8 + t] = bf_lo(kw.y); ks[(4 * ln + 3) * 8 + t] = bf_hi(kw.y);
    }
    __syncthreads();
    if (tid < 64) {
        const int t = tid >> 3, s = tid & 7; float a = 0.f;
        for (int d = 0; d < 256; ++d) a += qs[d * 8 + t] * ks[d * 8 + s];
        scs[t * 8 + s] = (t >= s) ? a * expf((float)(t - s) * lg) : 0.f;
    }
    const int eg = tid & 127, dq = tid >> 7, e = 4 * eg;
    f32x4 vd[8], cr[8];
#pragma unroll
    for (int s = 0; s < 8; ++s) {
        const u32x2 vw = *(const u32x2*)(z + (tok0 + s) * RIN + 4096 + h * 512 + e);
        const float dec = expf((float)(7 - s) * lg);
        vd[s] = (f32x4){bf_lo(vw.x) * dec, bf_hi(vw.x) * dec, bf_lo(vw.y) * dec, bf_hi(vw.y) * dec};
        cr[s] = (f32x4){0.f, 0.f, 0.f, 0.f};
    }
    const float g8 = expf(8.0f * lg);
    const float* sp = S_in + (((size_t)(b * 8 + h) * 256 + dq * 64) * 512 + e);
    float* dp = S_out + (((size_t)(b * 8 + h) * 256 + dq * 64) * 512 + e);
    for (int dd0 = 0; dd0 < 64; dd0 += 16) {
        f32x4 Sv[16];
#pragma unroll
        for (int j = 0; j < 16; ++j) Sv[j] = __builtin_nontemporal_load((const f32x4*)(sp + (size_t)(dd0 + j) * 512));
#pragma unroll
        for (int j = 0; j < 16; ++j) {
            const int d = dq * 64 + dd0 + j;
            const f32x4 S4 = Sv[j];
            const f32x4 qa = *(const LAS f32x4*)(qs + d * 8), qb = *(const LAS f32x4*)(qs + d * 8 + 4);
            const f32x4 ka = *(const LAS f32x4*)(ks + d * 8), kb = *(const LAS f32x4*)(ks + d * 8 + 4);
            cr[0] += qa[0] * S4; cr[1] += qa[1] * S4; cr[2] += qa[2] * S4; cr[3] += qa[3] * S4;
            cr[4] += qb[0] * S4; cr[5] += qb[1] * S4; cr[6] += qb[2] * S4; cr[7] += qb[3] * S4;
            f32x4 ns = S4 * g8;
            ns += ka[0] * vd[0]; ns += ka[1] * vd[1]; ns += ka[2] * vd[2]; ns += ka[3] * vd[3];
            ns += kb[0] * vd[4]; ns += kb[1] * vd[5]; ns += kb[2] * vd[6]; ns += kb[3] * vd[7];
            __builtin_nontemporal_store(ns, (f32x4*)(dp + (size_t)(dd0 + j) * 512));
        }
    }
#pragma unroll
    for (int t = 0; t < 8; ++t) *(LAS f32x4*)(red + ((dq * 8 + t) * 512 + e)) = cr[t];
    __syncthreads();
    {
        const int t = tid >> 6, e8 = (tid & 63) * 8;
        const float qd = expf((float)(t + 1) * lg);
        float acc[8];
#pragma unroll
        for (int j = 0; j < 8; ++j) acc[j] = 0.f;
#pragma unroll
        for (int q = 0; q < 4; ++q) {
            const f32x4 a = *(const LAS f32x4*)(red + ((q * 8 + t) * 512 + e8)), c = *(const LAS f32x4*)(red + ((q * 8 + t) * 512 + e8 + 4));
            acc[0] += a[0]; acc[1] += a[1]; acc[2] += a[2]; acc[3] += a[3]; acc[4] += c[0]; acc[5] += c[1]; acc[6] += c[2]; acc[7] += c[3];
        }
#pragma unroll
        for (int j = 0; j < 8; ++j) acc[j] *= qd;
#pragma unroll
        for (int s = 0; s < 8; ++s) {
            const float w = scs[t * 8 + s];
            const u32x4 vw = *(const u32x4*)(z + (tok0 + s) * RIN + 4096 + h * 512 + e8);
            acc[0] += w * bf_lo(vw.x); acc[1] += w * bf_hi(vw.x); acc[2] += w * bf_lo(vw.y); acc[3] += w * bf_hi(vw.y);
            acc[4] += w * bf_lo(vw.z); acc[5] += w * bf_hi(vw.z); acc[6] += w * bf_lo(vw.w); acc[7] += w * bf_hi(vw.w);
        }
        u32x4 w; w.x = pk2(acc[0], acc[1]); w.y = pk2(acc[2], acc[3]); w.z = pk2(acc[4], acc[5]); w.w = pk2(acc[6], acc[7]);
        *(u32x4*)(o + (tok0 + t) * 4096 + h * 512 + e8) = w;
    }
    __syncthreads();
}

__device__ __forceinline__ void xattn_prompt_item(const bf16_t* xq, const bf16_t* xq1, const bf16_t* memkv, const bf16_t* memvt, bf16_t* xo, int l, int it, int lane) {
    const int h = it & 3, qt = it >> 2, b = qt >> 8;
    const int l15 = lane & 15, g = lane >> 4;
    const size_t tok = (size_t)qt * 16 + l15;
    bf16x8 qf[4];
#pragma unroll
    for (int ks = 0; ks < 4; ++ks) {
        const u32x4 a = *(const u32x4*)(xq + tok * 512 + h * 128 + 32 * ks + 8 * g), c = *(const u32x4*)(xq1 + tok * 512 + h * 128 + 32 * ks + 8 * g);
        u32x4 w; w.x = pk2(bf_lo(a.x) + bf_lo(c.x), bf_hi(a.x) + bf_hi(c.x)); w.y = pk2(bf_lo(a.y) + bf_lo(c.y), bf_hi(a.y) + bf_hi(c.y));
        w.z = pk2(bf_lo(a.z) + bf_lo(c.z), bf_hi(a.z) + bf_hi(c.z)); w.w = pk2(bf_lo(a.w) + bf_lo(c.w), bf_hi(a.w) + bf_hi(c.w));
        qf[ks] = as_bf16x8(w);
    }
    f32x4 sc[16];
    float mx = -1e30f;
#pragma unroll
    for (int kt = 0; kt < 16; ++kt) {
        const bf16_t* kp = memkv + ((size_t)b * 256 + 16 * kt + l15) * 4096 + l * 1024 + h * 128 + 8 * g;
        f32x4 a = {0.f, 0.f, 0.f, 0.f};
#pragma unroll
        for (int ks = 0; ks < 4; ++ks) a = MFMA16(*(const bf16x8*)(kp + 32 * ks), qf[ks], a);
        a = a * 0.08838834764831845f;
        sc[kt] = a; mx = fmaxf(fmaxf(mx, fmaxf(a[0], a[1])), fmaxf(a[2], a[3]));
    }
    mx = fmaxf(mx, __shfl_xor(mx, 16)); mx = fmaxf(mx, __shfl_xor(mx, 32));
    float sum = 0.f;
#pragma unroll
    for (int kt = 0; kt < 16; ++kt)
#pragma unroll
        for (int j = 0; j < 4; ++j) { const float p = __expf(sc[kt][j] - mx); sc[kt][j] = p; sum += p; }
    sum += __shfl_xor(sum, 16); sum += __shfl_xor(sum, 32);
    const float inv = 1.0f / sum;
    f32x4 o[8];
#pragma unroll
    for (int mi = 0; mi < 8; ++mi) o[mi] = (f32x4){0.f, 0.f, 0.f, 0.f};
#pragma unroll
    for (int u = 0; u < 8; ++u) {
        u32x4 pw; pw.x = pk2(sc[2 * u][0] * inv, sc[2 * u][1] * inv); pw.y = pk2(sc[2 * u][2] * inv, sc[2 * u][3] * inv);
        pw.z = pk2(sc[2 * u + 1][0] * inv, sc[2 * u + 1][1] * inv); pw.w = pk2(sc[2 * u + 1][2] * inv, sc[2 * u + 1][3] * inv);
        const bf16x8 pb = as_bf16x8(pw);
        const int pos0 = 32 * u + 4 * g;
#pragma unroll
        for (int mi = 0; mi < 8; ++mi) {
            const bf16_t* vp = memvt + ((size_t)((l * 2 + b) * 512 + h * 128 + 16 * mi + l15)) * 256 + pos0;
            const s16x4 v0 = *(const s16x4*)vp, v1 = *(const s16x4*)(vp + 16);
            const bf16x8 va = (bf16x8){v0[0], v0[1], v0[2], v0[3], v1[0], v1[1], v1[2], v1[3]};
            o[mi] = MFMA16(va, pb, o[mi]);
        }
    }
#pragma unroll
    for (int mi = 0; mi < 8; ++mi) {
        u32x2 w; w.x = pk2(o[mi][0], o[mi][1]); w.y = pk2(o[mi][2], o[mi][3]);
        *(u32x2*)(xo + tok * 512 + h * 128 + 16 * mi + 4 * g) = w;
    }
}

__device__ __forceinline__ void xattn_sample_item(LAS float* wl, const bf16_t* xq, const float* mk, const float* mv, bf16_t* xo, int it, int lane) {
    const int h = it & 3, b = it >> 2;
    LAS float* qs = wl;
    LAS float* pT = wl + 1024;
    const size_t tok0 = (size_t)T_P + b * 8;
#pragma unroll
    for (int t = 0; t < 8; ++t) {
        const unsigned qw = *(const unsigned*)(xq + (tok0 + t) * 512 + h * 128 + 2 * lane);
        *(LAS f32x2*)(qs + t * 128 + 2 * lane) = (f32x2){bf_lo(qw) * 0.08838834764831845f, bf_hi(qw) * 0.08838834764831845f};
    }
    __builtin_amdgcn_wave_barrier();
    asm volatile("s_waitcnt lgkmcnt(0)" ::: "memory");
    float s[4][8];
#pragma unroll
    for (int ps = 0; ps < 4; ++ps) {
        const int key = lane + 64 * ps;
#pragma unroll
        for (int t = 0; t < 8; ++t) s[ps][t] = 0.f;
        const f32x4* kp = (const f32x4*)(mk + (((size_t)b * 256 + key) * 4 + h) * 128);
#pragma unroll 4
        for (int d4 = 0; d4 < 32; ++d4) {
            const f32x4 k4 = kp[d4];
#pragma unroll
            for (int t = 0; t < 8; ++t) { const f32x4 q4 = *(const LAS f32x4*)(qs + t * 128 + 4 * d4); s[ps][t] += (k4[0] * q4[0] + k4[1] * q4[1]) + (k4[2] * q4[2] + k4[3] * q4[3]); }
        }
    }
#pragma unroll
    for (int t = 0; t < 8; ++t) {
        float m = fmaxf(fmaxf(s[0][t], s[1][t]), fmaxf(s[2][t], s[3][t])); m = wave_max(m);
        const float p0 = __expf(s[0][t] - m), p1 = __expf(s[1][t] - m), p2 = __expf(s[2][t] - m), p3 = __expf(s[3][t] - m);
        const float inv = 1.0f / wave_sum((p0 + p1) + (p2 + p3));
        pT[lane * 8 + t] = p0 * inv; pT[(lane + 64) * 8 + t] = p1 * inv; pT[(lane + 128) * 8 + t] = p2 * inv; pT[(lane + 192) * 8 + t] = p3 * inv;
    }
    __builtin_amdgcn_wave_barrier();
    asm volatile("s_waitcnt lgkmcnt(0)" ::: "memory");
    f32x2 o[8];
#pragma unroll
    for (int t = 0; t < 8; ++t) o[t] = (f32x2){0.f, 0.f};
#pragma unroll 4
    for (int key = 0; key < 256; ++key) {
        const f32x2 v = *(const f32x2*)(mv + (((size_t)b * 256 + key) * 4 + h) * 128 + 2 * lane);
        const f32x4 pa = *(const LAS f32x4*)(pT + key * 8), pb = *(const LAS f32x4*)(pT + key * 8 + 4);
        o[0] += pa[0] * v; o[1] += pa[1] * v; o[2] += pa[2] * v; o[3] += pa[3] * v; o[4] += pb[0] * v; o[5] += pb[1] * v; o[6] += pb[2] * v; o[7] += pb[3] * v;
    }
#pragma unroll
    for (int t = 0; t < 8; ++t) *(unsigned*)(xo + (tok0 + t) * 512 + h * 128 + 2 * lane) = pk2(o[t][0], o[t][1]);
    __builtin_amdgcn_wave_barrier();
}

#define XB_TMO      128
#define XB_XCNT(j)  (256  + 64 * (j))
#define XB_XSUB(j)  (1280 + 64 * (j))
#define XB_XGEN(j)  (2304 + 64 * (j))
#define XB_TOP      3328
#define XB_TOPGEN   3392
#define XCD_BAR_WORDS 3456
#define XB_SPIN_CAP (1u << 18)

__device__ __forceinline__ unsigned xb_ld(unsigned* p)              { return __hip_atomic_load(p, __ATOMIC_RELAXED, __HIP_MEMORY_SCOPE_AGENT); }
__device__ __forceinline__ unsigned xb_add(unsigned* p, unsigned v) { return __hip_atomic_fetch_add(p, v, __ATOMIC_RELAXED, __HIP_MEMORY_SCOPE_AGENT); }
__device__ __forceinline__ unsigned xb_xcc_id() { return (unsigned)__builtin_amdgcn_s_getreg((3 << 11) | 20) & 0xFu; }
#define XB_SPIN(cond, bar) do { unsigned _sp = 0; while (cond) { __builtin_amdgcn_s_sleep(1); \
    if ((++_sp & 255u) == 0u) { if (xb_ld(&(bar)[XB_TMO])) break; if (_sp > XB_SPIN_CAP) { atomicAdd(&(bar)[XB_TMO], 1u); break; } } } } while (0)

struct XcdBarrier {
    unsigned* bar; unsigned x;
    volatile LAS unsigned* st;
};

__device__ __forceinline__ XcdBarrier xcd_barrier_post(unsigned* bar, volatile LAS unsigned* st) {
    XcdBarrier b; b.bar = bar; b.x = xb_xcc_id(); b.st = st;
    if (threadIdx.x == 0) (void)xb_add(&bar[XB_XCNT(b.x)], 1u);
    return b;
}
__device__ __forceinline__ void xcd_barrier_complete(unsigned* bar, unsigned x, unsigned& nloc, unsigned& nx) {
    const unsigned G = gridDim.x * gridDim.y * gridDim.z;
    unsigned sum, cnt, mine, sp = 0u;
    for (;;) {
        sum = 0u; cnt = 0u; mine = 0u;
#pragma unroll
        for (unsigned j = 0; j < 16; ++j) { const unsigned c = xb_ld(&bar[XB_XCNT(j)]); sum += c; cnt += (c > 0u) ? 1u : 0u; mine = (j == x) ? c : mine; }
        if (sum == G) break;
        __builtin_amdgcn_s_sleep(1);
        if ((++sp & 255u) == 0u) { if (xb_ld(&bar[XB_TMO])) break; if (sp > XB_SPIN_CAP) { atomicAdd(&bar[XB_TMO], 1u); break; } }
    }
    nloc = mine > 0u ? mine : 1u; nx = cnt > 0u ? cnt : 1u;
}

__device__ __forceinline__ void xcd_barrier(const XcdBarrier& b) {
    asm volatile("s_waitcnt vmcnt(0)" ::: "memory");
    __syncthreads();
    if (threadIdx.x == 0) {
        unsigned* bar = b.bar;
        __builtin_amdgcn_s_waitcnt(0);
        unsigned nloc = b.st[0], nx = b.st[1];
        if (nloc == 0u) { xcd_barrier_complete(bar, b.x, nloc, nx); b.st[0] = nloc; b.st[1] = nx; }
        const unsigned old = xb_add(&bar[XB_XSUB(b.x)], 1u);
        const unsigned gen = old / nloc;
        if (old + 1u == (gen + 1u) * nloc) {
            __builtin_amdgcn_fence(__ATOMIC_RELEASE, "agent");
            asm volatile("s_waitcnt vmcnt(0)" ::: "memory");
            const unsigned og = xb_add(&bar[XB_TOP], 1u);
            const unsigned tg = og / nx;
            if (og + 1u == (tg + 1u) * nx) xb_add(&bar[XB_TOPGEN], 1u);
            else XB_SPIN(xb_ld(&bar[XB_TOPGEN]) == tg, bar);
            __builtin_amdgcn_fence(__ATOMIC_ACQUIRE, "agent");
            xb_add(&bar[XB_XGEN(b.x)], 1u);
            asm volatile("s_waitcnt vmcnt(0)" ::: "memory");
        } else {
            XB_SPIN(xb_ld(&bar[XB_XGEN(b.x)]) == gen, bar);
            __builtin_amdgcn_fence(__ATOMIC_ACQUIRE, "agent");
            asm volatile("s_waitcnt vmcnt(0)" ::: "memory");
        }
    }
    __syncthreads();
}


__device__ __forceinline__ void xattn_sample_block(LAS unsigned char* lds, const bf16_t* xq, const bf16_t* xq1, const float* mk, const float* mv, bf16_t* xo, int it, int tid) {
    const int h = it & 3, b = it >> 2, wave = tid >> 6, lane = tid & 63;
    LAS float* qs = (LAS float*)lds;
    LAS float* pT = qs + 1024;
    LAS float* ml = pT + 2048;
    LAS float* po = ml + 64;
    const size_t tok0 = (size_t)T_P + b * 8;
    if (wave < 4) {
#pragma unroll
        for (int t2 = 0; t2 < 2; ++t2) {
            const int t = wave * 2 + t2;
            const unsigned qw = *(const unsigned*)(xq + (tok0 + t) * 512 + h * 128 + 2 * lane), qw1 = *(const unsigned*)(xq1 + (tok0 + t) * 512 + h * 128 + 2 * lane);
            *(LAS f32x2*)(qs + t * 128 + 2 * lane) = (f32x2){(bf_lo(qw) + bf_lo(qw1)) * 0.08838834764831845f, (bf_hi(qw) + bf_hi(qw1)) * 0.08838834764831845f};
        }
    }
    __syncthreads();
    if (wave < 4) {
        const int key = lane + 64 * wave;
        float s[8];
#pragma unroll
        for (int t = 0; t < 8; ++t) s[t] = 0.f;
        const f32x4* kp = (const f32x4*)(mk + (((size_t)b * 256 + key) * 4 + h) * 128);
#pragma unroll 8
        for (int d4 = 0; d4 < 32; ++d4) {
            const f32x4 k4 = kp[d4];
#pragma unroll
            for (int t = 0; t < 8; ++t) { const f32x4 q4 = *(const LAS f32x4*)(qs + t * 128 + 4 * d4); s[t] += (k4[0] * q4[0] + k4[1] * q4[1]) + (k4[2] * q4[2] + k4[3] * q4[3]); }
        }
#pragma unroll
        for (int t = 0; t < 8; ++t) {
            const float m = wave_max(s[t]); const float p = __expf(s[t] - m); const float l = wave_sum(p);
            pT[key * 8 + t] = p;
            if (lane == 0) { ml[(wave * 8 + t) * 2] = m; ml[(wave * 8 + t) * 2 + 1] = l; }
        }
        __builtin_amdgcn_wave_barrier();
        asm volatile("s_waitcnt lgkmcnt(0)" ::: "memory");
        f32x2 o[8];
#pragma unroll
        for (int t = 0; t < 8; ++t) o[t] = (f32x2){0.f, 0.f};
#pragma unroll 16
        for (int kk = 0; kk < 64; ++kk) {
            const int k2 = 64 * wave + kk;
            const f32x2 v = *(const f32x2*)(mv + (((size_t)b * 256 + k2) * 4 + h) * 128 + 2 * lane);
            const f32x4 pa = *(const LAS f32x4*)(pT + k2 * 8), pb = *(const LAS f32x4*)(pT + k2 * 8 + 4);
            o[0] += pa[0] * v; o[1] += pa[1] * v; o[2] += pa[2] * v; o[3] += pa[3] * v; o[4] += pb[0] * v; o[5] += pb[1] * v; o[6] += pb[2] * v; o[7] += pb[3] * v;
        }
#pragma unroll
        for (int t = 0; t < 8; ++t) *(LAS f32x2*)(po + (wave * 8 + t) * 128 + 2 * lane) = o[t];
    }
    __syncthreads();
    if (wave < 4) {
#pragma unroll
        for (int t2 = 0; t2 < 2; ++t2) {
            const int t = wave * 2 + t2;
            float m = ml[(0 * 8 + t) * 2];
#pragma unroll
            for (int w = 1; w < 4; ++w) m = fmaxf(m, ml[(w * 8 + t) * 2]);
            float den = 0.f; f32x2 acc = {0.f, 0.f};
#pragma unroll
            for (int w = 0; w < 4; ++w) {
                const float sc = __expf(ml[(w * 8 + t) * 2] - m);
                den += sc * ml[(w * 8 + t) * 2 + 1];
                acc += sc * *(const LAS f32x2*)(po + (w * 8 + t) * 128 + 2 * lane);
            }
            const float inv = 1.0f / den;
            *(unsigned*)(xo + (tok0 + t) * 512 + h * 128 + 2 * lane) = pk2(acc[0] * inv, acc[1] * inv);
        }
    }
    __syncthreads();
}


__device__ __forceinline__ void sample_out_block(LAS unsigned char* lds, const bf16_t* A, const bf16_t* Bt, int K, bf16_t* xb, float* sspart, int blk, int tid) {
    const int wave = tid >> 6, lane = tid & 63, l15 = lane & 15, g = lane >> 4;
    const int rt = blk >> 5, cg = blk & 31, r0 = T_P + 32 * rt;
    const int kq = K >> 3;
    f32x4 acc[2][4];
#pragma unroll
    for (int ra = 0; ra < 2; ++ra)
#pragma unroll
        for (int nt = 0; nt < 4; ++nt) acc[ra][nt] = (f32x4){0.f, 0.f, 0.f, 0.f};
    {
        const bf16_t* ap = A + (size_t)(r0 + l15) * K + wave * kq + 8 * g;
        const bf16_t* bp = Bt + (size_t)(64 * cg + l15) * K + wave * kq + 8 * g;
        bf16x8 af[2][2], bf[2][4], afn[2][2], bfn[2][4];
#pragma unroll
        for (int s = 0; s < 2; ++s) {
#pragma unroll
            for (int ra = 0; ra < 2; ++ra) af[s][ra] = *(const bf16x8*)(ap + (size_t)(16 * ra) * K + 32 * s);
#pragma unroll
            for (int nt = 0; nt < 4; ++nt) bf[s][nt] = *(const bf16x8*)(bp + (size_t)(16 * nt) * K + 32 * s);
        }
        for (int k0 = 0; k0 < kq; k0 += 64) {
            const int k1 = (k0 + 64 < kq) ? k0 + 64 : k0;
#pragma unroll
            for (int s = 0; s < 2; ++s) {
#pragma unroll
                for (int ra = 0; ra < 2; ++ra) afn[s][ra] = *(const bf16x8*)(ap + (size_t)(16 * ra) * K + k1 + 32 * s);
#pragma unroll
                for (int nt = 0; nt < 4; ++nt) bfn[s][nt] = *(const bf16x8*)(bp + (size_t)(16 * nt) * K + k1 + 32 * s);
            }
#pragma unroll
            for (int s = 0; s < 2; ++s)
#pragma unroll
                for (int ra = 0; ra < 2; ++ra)
#pragma unroll
                    for (int nt = 0; nt < 4; ++nt) acc[ra][nt] = MFMA16(af[s][ra], bf[s][nt], acc[ra][nt]);
#pragma unroll
            for (int s = 0; s < 2; ++s) {
#pragma unroll
                for (int ra = 0; ra < 2; ++ra) af[s][ra] = afn[s][ra];
#pragma unroll
                for (int nt = 0; nt < 4; ++nt) bf[s][nt] = bfn[s][nt];
            }
        }
    }
    LAS f32x4* part = (LAS f32x4*)lds;
#pragma unroll
    for (int ra = 0; ra < 2; ++ra)
#pragma unroll
        for (int nt = 0; nt < 4; ++nt) part[(wave * 8 + ra * 4 + nt) * 64 + lane] = acc[ra][nt];
    __syncthreads();
    if (wave < 2) {
        const int ra = wave;
        f32x4 sum[4];
#pragma unroll
        for (int nt = 0; nt < 4; ++nt) {
            sum[nt] = part[(0 * 8 + ra * 4 + nt) * 64 + lane];
#pragma unroll
            for (int w = 1; w < 8; ++w) sum[nt] += part[(w * 8 + ra * 4 + nt) * 64 + lane];
        }
        float ss[4] = {0.f, 0.f, 0.f, 0.f};
#pragma unroll
        for (int j = 0; j < 4; ++j)
#pragma unroll
            for (int nt = 0; nt < 4; ++nt) {
                bf16_t* xp = xb + (size_t)(r0 + 16 * ra + 4 * g + j) * 2048 + 64 * cg + 16 * nt + l15;
                const bf16_t nv = f2bf(bf1(*xp) + sum[nt][j]);
                *xp = nv; const float r = bf1(nv); ss[j] += r * r;
            }
#pragma unroll
        for (int j = 0; j < 4; ++j) {
            float s = ss[j];
            s += __shfl_xor(s, 1); s += __shfl_xor(s, 2); s += __shfl_xor(s, 4); s += __shfl_xor(s, 8);
            if (l15 == 0) sspart[(size_t)(r0 + 16 * ra + 4 * g + j) * 32 + cg] = s;
        }
    }
    __syncthreads();
}

__global__ void __launch_bounds__(NTHREADS, 2) hybrid_fwd(Params P) {
    extern __shared__ __attribute__((aligned(16))) unsigned char lds_raw[];
    LAS unsigned char* lds = (LAS unsigned char*)lds_raw;
    cg::grid_group grid = cg::this_grid();
    if (threadIdx.x < 4) ((LAS unsigned*)(lds + LDS_BYTES - 16))[threadIdx.x] = 0u;
    __syncthreads();
    if (P.ph_hi - P.ph_lo > 1) (void)xcd_barrier_post((unsigned*)(P.ws + WS_BAR), (volatile LAS unsigned*)(lds + LDS_BYTES - 16));
    if (P.ph_hi < 0) grid.sync();
    const int tid0 = threadIdx.x, bid0 = blockIdx.x;
    int pc = 0; const int ph_lo = P.ph_lo, ph_hi = P.ph_hi;
    const int G = gridDim.x, NGW = G * 8;
#define PHASE_IDS int tid_l = tid0; asm volatile("" : "+v"(tid_l)); const int tid = tid_l, lane = tid & 63, wave = __builtin_amdgcn_readfirstlane(tid >> 6); \
    int bid_l = bid0; asm volatile("" : "+s"(bid_l)); const int bid = bid_l, gw = bid * 8 + wave; (void)lane; (void)gw; (void)tid;
#define OPQ64(v) asm volatile("" : "+s"(v))
#define GAS __attribute__((address_space(1)))
#if defined(__HIP_DEVICE_COMPILE__)
#define ASSUME_GLOBAL(p) do { __builtin_assume(!__builtin_amdgcn_is_shared((const void*)(p))); __builtin_assume(!__builtin_amdgcn_is_private((const void*)(p))); } while (0)
#else
#define ASSUME_GLOBAL(p) do { } while (0)
#endif
#define INP(name, idx) const float* name; { int ii_ = (idx); asm volatile("" : "+s"(ii_)); { const GAS float* g_ = (const GAS float*)P.in[ii_]; asm volatile("" : "+s"(g_)); name = (const float*)g_; } }
#define WSB(name, type, off) type* name; { GAS unsigned char* w_ = (GAS unsigned char*)P.ws; OPQ64(w_); name = (type*)(w_ + (off)); }
#define OUTP(name) float* name; { GAS float* o_ = (GAS float*)P.out; OPQ64(o_); name = (float*)o_; }
#ifndef REPMASK
#define REPMASK 0
#endif
#define REP(k) ((((REPMASK) >> (k)) & 1) ? 2 : 1)
#ifndef PHMASK
#define PHMASK 0xFFFFFFFF
#endif
#define PHS(k) (((PHMASK) >> (k)) & 1)
#define PH(k) ((((PHMASK) >> (k)) & 1) && pc >= ph_lo && pc < ph_hi)
#define GRID_SYNC() do { if (pc >= ph_lo && pc + 1 < ph_hi) { GAS unsigned char* w_ = (GAS unsigned char*)P.ws; OPQ64(w_); XcdBarrier xb_; xb_.bar = (unsigned*)(w_ + WS_BAR); xb_.x = xb_xcc_id(); xb_.st = (volatile LAS unsigned*)(lds + LDS_BYTES - 16); xcd_barrier(xb_); } ++pc; } while (0)
#define RUN_GEMM(EPI, Aptr, Bptr, Mv, Nv, Kv, Eobj, coff) do { pg8::Gemm gg{(const pg8::bf16_t*)(Aptr), (const pg8::bf16_t*)(Bptr), (Mv), (Nv), (Kv), (Kv)}; \
        pg8::StaticOrder SO; SO.init((Mv), (Nv), G, (bid + (coff)) % G); pg8::gemm_phase<EPI, pg8::StaticOrder, true, true>(lds, gg, SO, (Eobj)); } while (0)

    for (int rep_ = 0; rep_ < (PH(0) ? REP(0) : 0); ++rep_) {
                PHASE_IDS
        INP(x_prompt, 0) INP(x_sample, 1) INP(mem_prompt, 7) INP(norm_mix, 8) INP(w_in_even, 9) INP(w_out_even, 15) INP(w_in_ret, 16) INP(w_out_ret, 17)
        INP(norm_cross, 18) INP(norm_mem, 19) INP(w_xq, 20) INP(w_xk, 21) INP(w_xv, 22) INP(w_xo, 23)
        WSB(WinE, bf16_t, WS_WINE) WSB(WoutE, bf16_t, WS_WOUTE) WSB(WinR, bf16_t, WS_WINR) WSB(WoutR, bf16_t, WS_WOUTR)
        WSB(Wxq, bf16_t, WS_WXQ) WSB(Wxo, bf16_t, WS_WXO) WSB(Wxkv, bf16_t, WS_WXKV)
        WSB(X, float, WS_X) WSB(XB, bf16_t, WS_XB) WSB(SS, float, WS_SS) WSB(MEMB, bf16_t, WS_MEMB) WSB(MEMSS, float, WS_MEMSS)
        LAS float* scr = (LAS float*)(lds + wave * 16384);
        constexpr int NITEMS = 2 * (5376 + 2048 + 12288 + 4096) + 4 * 2048;
        for (int it = gw; it < NITEMS; it += NGW) {
            int r = it;
#define SEG(cnt, ...) if (r < (cnt)) { p0_transpose_item(__VA_ARGS__); continue; } r -= (cnt);
            SEG(5376, w_in_even, 2048, EIN, WinE, 0, scr, r, lane, norm_mix, 0, 0, 1.f)
            SEG(5376, w_in_even + (size_t)2048 * EIN, 2048, EIN, WinE + (size_t)EIN * 2048, 0, scr, r, lane, norm_mix + 2 * 2048, 0, 0, 1.f)
            SEG(2048, w_out_even, 2048, 2048, WoutE, 0, scr, r, lane, nullptr, 0, 0, 1.f)
            SEG(2048, w_out_even + (size_t)2048 * 2048, 2048, 2048, WoutE + (size_t)2048 * 2048, 0, scr, r, lane, nullptr, 0, 0, 1.f)
            SEG(12288, w_in_ret, 2048, RIN, WinR, 0, scr, r, lane, norm_mix + 1 * 2048, 2048, 4096, 0.0625f)
            SEG(12288, w_in_ret + (size_t)2048 * RIN, 2048, RIN, WinR + (size_t)RIN * 2048, 0, scr, r, lane, norm_mix + 3 * 2048, 2048, 4096, 0.0625f)
            SEG(4096, w_out_ret, 4096, 2048, WoutR, 0, scr, r, lane, nullptr, 0, 0, 1.f)
            SEG(4096, w_out_ret + (size_t)4096 * 2048, 4096, 2048, WoutR + (size_t)2048 * 4096, 0, scr, r, lane, nullptr, 0, 0, 1.f)
            {
                const int l = r >> 11, q = (r >> 9) & 3, rr = r & 511;
                if (q == 0) p0_transpose_item(w_xq + (size_t)l * 2048 * 512, 2048, 512, Wxq + (size_t)l * 512 * 2048, 0, scr, rr, lane, norm_cross + l * 2048, 0, 0, 1.f);
                else if (q == 1) p0_transpose_item(w_xo + (size_t)l * 512 * 2048, 512, 2048, Wxo + (size_t)l * 2048 * 512, 0, scr, rr, lane, nullptr, 0, 0, 1.f);
                else if (q == 2) p0_transpose_item(w_xk + (size_t)l * 2048 * 512, 2048, 512, Wxkv, l * 1024, scr, rr, lane, norm_mem + l * 2048, 0, 0, 1.f);
                else p0_transpose_item(w_xv + (size_t)l * 2048 * 512, 2048, 512, Wxkv, l * 1024 + 512, scr, rr, lane, norm_mem + l * 2048, 0, 0, 1.f);
            }
#undef SEG
        }
        for (int m = gw; m < T_ALL + 512; m += NGW) {
            if (m < T_P) p0_row(x_prompt + (size_t)m * 2048, nullptr, XB + (size_t)m * 2048, SS + (size_t)m * 32, lane);
            else if (m < T_ALL) p0_row(x_sample + (size_t)(m - T_P) * 2048, nullptr, XB + (size_t)m * 2048, SS + (size_t)m * 32, lane);
            else { const int mm = m - T_ALL; p0_row(mem_prompt + (size_t)mm * 2048, nullptr, MEMB + (size_t)mm * 2048, MEMSS + (size_t)mm * 32, lane); }
        }
    }
    GRID_SYNC();

#pragma unroll 1
    for (int l = 0; l < 4; ++l) {
        const int li = l >> 1;
        if ((l & 1) == 0) {
            for (int rep_ = 0; rep_ < (PH(1) ? REP(1) : 0); ++rep_) {
                PHASE_IDS
                WSB(Z, bf16_t, WS_Z) WSB(SS, float, WS_SS) WSB(VT, bf16_t, WS_VT) WSB(XB, bf16_t, WS_XB) WSB(WinE, bf16_t, WS_WINE)
                pg8::EpiZ E{Z, EIN, SS, 5, 9, 17, 21, 4, VT, T_ALL};
                RUN_GEMM(pg8::EpiZ, XB, WinE + (size_t)li * EIN * 2048, T_ALL, EIN, 2048, E, 0);
            }
            if (PH(1) && l == 0) {
                PHASE_IDS
                WSB(MEMKV, bf16_t, WS_MEMKV) WSB(MEMVT, bf16_t, WS_MEMVT) WSB(MEMSS, float, WS_MEMSS) WSB(MEMB, bf16_t, WS_MEMB) WSB(Wxkv, bf16_t, WS_WXKV) OUTP(out)
                pg8::EpiMem EM{MEMKV, MEMVT, out + OUT_MKP, out + OUT_MVP, MEMSS};
                RUN_GEMM(pg8::EpiMem, MEMB, Wxkv, 512, 4096, 2048, EM, G - (33 * 21) % G);
            }
            GRID_SYNC();
            for (int rep_ = 0; rep_ < (PH(2) ? REP(2) : 0); ++rep_) {
                PHASE_IDS
                INP(cache_win_k, 2) INP(cache_win_v, 3) INP(attn_sinks, 10) INP(w_spatial, 11) INP(b_spatial, 12) INP(norm_v_g, 13) INP(norm_v_b, 14) OUTP(out)
                WSB(Z, bf16_t, WS_Z) WSB(MIX, bf16_t, WS_MIX) WSB(VT, bf16_t, WS_VT)
                const float* sinks = attn_sinks + li * 16;
                const float* w_s = w_spatial + (size_t)li * 4 * 128 * 128; const float* b_s = b_spatial + li * 4 * 128;
                const float* lg_ = norm_v_g + li * 1024; const float* lb_ = norm_v_b + li * 1024;
                const float* ck = cache_win_k + (size_t)li * 32 * 128 * 128; const float* cv = cache_win_v + (size_t)li * 32 * 128 * 128;
                if (PHS(12)) for (int item = bid; item < 256; item += G) gate_prompt_item(lds, Z, MIX, w_s, b_s, lg_, lb_, item, tid);
                if (PHS(13)) {
                    if (NGW == 2048) {
                        if ((gw & 3) == 0) attn_prompt_item(Z, VT, MIX, sinks, 7680 + (gw >> 2), lane);
                        else { const int hw = (gw >> 2) * 3 + (gw & 3) - 1; for (int j = 0; j < 5; ++j) attn_prompt_item(Z, VT, MIX, sinks, j * 1536 + hw, lane); }
                    } else for (int it = gw; it < 8192; it += NGW) attn_prompt_item(Z, VT, MIX, sinks, it, lane);
                }
                LAS float* wl = (LAS float*)(lds + wave * 12288);
                if (PHS(14)) for (int it = gw; it < 2048; it += NGW) if ((it & 3) == 0) attn_sample_item(wl, Z, MIX, sinks, ck, cv, it >> 2, lane);
                if (PHS(15)) for (int it = gw; it < 2048; it += NGW) if ((it & 7) == 4) gate_sample_item(Z, MIX, out + OUT_CVS + (size_t)li * 262144, w_s, b_s, lg_, lb_, it >> 3, lane);
                const int gt = bid * NTHREADS + tid, NGT = G * NTHREADS;
                for (int idx = gt; idx < 4096; idx += NGT) {
                    const int c8 = idx & 15, j = (idx >> 4) & 127, b = idx >> 11;
                    const size_t tk = (size_t)b * SEQL + 3968 + j;
                    const u32x4 kw = *(const u32x4*)(Z + tk * EIN + 1024 + 8 * c8), vw = *(const u32x4*)(Z + tk * EIN + 1152 + 8 * c8);
                    float* ko = out + OUT_WKP + (size_t)li * 32768 + (size_t)idx * 8; float* vo = out + OUT_WVP + (size_t)li * 32768 + (size_t)idx * 8;
                    *(f32x4*)ko = (f32x4){bf_lo(kw.x), bf_hi(kw.x), bf_lo(kw.y), bf_hi(kw.y)}; *(f32x4*)(ko + 4) = (f32x4){bf_lo(kw.z), bf_hi(kw.z), bf_lo(kw.w), bf_hi(kw.w)};
                    *(f32x4*)vo = (f32x4){bf_lo(vw.x), bf_hi(vw.x), bf_lo(vw.y), bf_hi(vw.y)}; *(f32x4*)(vo + 4) = (f32x4){bf_lo(vw.z), bf_hi(vw.z), bf_lo(vw.w), bf_hi(vw.w)};
                }
                for (int idx = gt; idx < 65536; idx += NGT) {
                    const int c8 = idx & 15, j = (idx >> 4) & 127, b = idx >> 11;
                    float* ko = out + OUT_WKS + (size_t)li * 524288 + (size_t)idx * 8; float* vo = out + OUT_WVS + (size_t)li * 524288 + (size_t)idx * 8;
                    if (j < 120) {
                        const float* kp = ck + ((size_t)b * 128 + j + 8) * 128 + 8 * c8; const float* vp = cv + ((size_t)b * 128 + j + 8) * 128 + 8 * c8;
                        const f32x4 k0 = *(const f32x4*)kp, k1 = *(const f32x4*)(kp + 4), v0 = *(const f32x4*)vp, v1 = *(const f32x4*)(vp + 4);
                        *(f32x4*)ko = k0; *(f32x4*)(ko + 4) = k1; *(f32x4*)vo = v0; *(f32x4*)(vo + 4) = v1;
                    } else {
                        const size_t tk = (size_t)T_P + b * 8 + (j - 120);
                        const u32x4 kw = *(const u32x4*)(Z + tk * EIN + 1024 + 8 * c8), vw = *(const u32x4*)(Z + tk * EIN + 1152 + 8 * c8);
                        *(f32x4*)ko = (f32x4){bf_lo(kw.x), bf_hi(kw.x), bf_lo(kw.y), bf_hi(kw.y)}; *(f32x4*)(ko + 4) = (f32x4){bf_lo(kw.z), bf_hi(kw.z), bf_lo(kw.w), bf_hi(kw.w)};
                        *(f32x4*)vo = (f32x4){bf_lo(vw.x), bf_hi(vw.x), bf_lo(vw.y), bf_hi(vw.y)}; *(f32x4*)(vo + 4) = (f32x4){bf_lo(vw.z), bf_hi(vw.z), bf_lo(vw.w), bf_hi(vw.w)};
                    }
                }
            }
            GRID_SYNC();
            if (PH(3)) {
                PHASE_IDS
                WSB(X, float, WS_X) WSB(XB, bf16_t, WS_XB) WSB(SS, float, WS_SS) WSB(MIX, bf16_t, WS_MIX) WSB(WoutE, bf16_t, WS_WOUTE)
                pg8::EpiRes E{XB, SS};
                for (int blk = bid; blk < 256; blk += G) sample_out_block(lds, MIX, WoutE + (size_t)li * 2048 * 2048, 2048, XB, SS, blk, tid);
                RUN_GEMM(pg8::EpiRes, MIX, WoutE + (size_t)li * 2048 * 2048, T_P, 2048, 2048, E, 0);
            }
            GRID_SYNC();
        } else {
            for (int rep_ = 0; rep_ < (PH(4) ? REP(4) : 0); ++rep_) {
                PHASE_IDS
                WSB(Z, bf16_t, WS_Z) WSB(SS, float, WS_SS) WSB(VT, bf16_t, WS_VT) WSB(XB, bf16_t, WS_XB) WSB(WinR, bf16_t, WS_WINR)
                pg8::EpiZ E{Z, RIN, SS, 32, 48, 0, 0, -1, VT, T_ALL};
                RUN_GEMM(pg8::EpiZ, XB, WinR + (size_t)li * RIN * 2048, T_P, RIN, 2048, E, 0);
            }
            GRID_SYNC();
            for (int rep_ = 0; rep_ < (PH(5) ? REP(5) : 0); ++rep_) {
                PHASE_IDS
                INP(state_ret, 4) OUTP(out) WSB(Z, bf16_t, WS_Z) WSB(OB, bf16_t, WS_O)
                const int half = G / 2;
                if (bid < half) {
                    if (PHS(16)) for (int blk = bid; blk < 128; blk += half) { const int item = (half == 128) ? ((((blk & 7) * 2 + (blk >> 6)) << 3) | ((blk >> 3) & 7)) : blk;
                        ret_prompt_item(lds, Z, OB, out + OUT_RSP + (size_t)li * 2097152, item, tid); }
                } else {
                    {
                        WSB(XBs, bf16_t, WS_XB) WSB(SSs, float, WS_SS) WSB(WinRs, bf16_t, WS_WINR) WSB(VTs, bf16_t, WS_VT) WSB(CNT, unsigned, WS_BAR)
                        pg8::EpiZ Es{Z + (size_t)T_P * RIN, RIN, SSs + (size_t)T_P * 32, 32, 48, 0, 0, -1, VTs, T_ALL};
                        pg8::Gemm gs{(const pg8::bf16_t*)(XBs + (size_t)T_P * 2048), (const pg8::bf16_t*)(WinRs + (size_t)li * RIN * 2048), 256, RIN, 2048, 2048};
                        pg8::StaticOrder SOs; SOs.init(256, RIN, G - half, bid - half); pg8::gemm_phase<pg8::EpiZ, pg8::StaticOrder, true, true>(lds, gs, SOs, Es);
                        unsigned* cw = CNT + 3600 + 64 * li;
                        const bool has_unit = (bid - half) < 48;
                        if (has_unit) { asm volatile("s_waitcnt vmcnt(0)" ::: "memory"); __builtin_amdgcn_fence(__ATOMIC_RELEASE, "agent"); asm volatile("s_waitcnt vmcnt(0)" ::: "memory"); }
                        __syncthreads();
                        if (tid == 0) {
                            if (has_unit) __hip_atomic_fetch_add(cw, 1u, __ATOMIC_RELAXED, __HIP_MEMORY_SCOPE_AGENT);
                            unsigned spins = 0;
                            while (__hip_atomic_load(cw, __ATOMIC_RELAXED, __HIP_MEMORY_SCOPE_AGENT) < 48u) { __builtin_amdgcn_s_sleep(8); if (++spins > (1u << 22)) break; }
                            __builtin_amdgcn_fence(__ATOMIC_ACQUIRE, "agent"); asm volatile("s_waitcnt vmcnt(0)" ::: "memory");
                        }
                        __syncthreads();
                    }
                    if (PHS(17)) for (int item = bid - half; item < 256; item += (G - half))
                        ret_sample_item(lds, Z, OB, state_ret + (size_t)li * 33554432, out + OUT_RSS + (size_t)li * 33554432, item, tid);
                }
            }
            GRID_SYNC();
            for (int rep_ = 0; rep_ < (PH(6) ? REP(6) : 0); ++rep_) {
                PHASE_IDS
                WSB(Z, bf16_t, WS_Z) WSB(OB, bf16_t, WS_O) WSB(MIX, bf16_t, WS_MIX)
                for (int it0 = gw; it0 < T_ALL * 8; it0 += 4 * NGW) {
                    u32x4 av[4], gv[4];
#pragma unroll
                    for (int r = 0; r < 4; ++r) {
                        int it = it0 + r * NGW; it = it < T_ALL * 8 ? it : gw;
                        const int h = it & 7; const size_t tok = it >> 3;
                        av[r] = *(const u32x4*)(OB + tok * 4096 + h * 512 + 8 * lane); gv[r] = *(const u32x4*)(Z + tok * RIN + 8192 + h * 512 + 8 * lane);
                    }
#pragma unroll
                    for (int r = 0; r < 4; ++r) {
                        const int it = it0 + r * NGW;
                        const int h = it & 7; const size_t tok = it >> 3;
                        const u32x4 a = av[r], gq = gv[r];
                        float v[8] = {bf_lo(a.x), bf_hi(a.x), bf_lo(a.y), bf_hi(a.y), bf_lo(a.z), bf_hi(a.z), bf_lo(a.w), bf_hi(a.w)};
                        float s = 0.f;
#pragma unroll
                        for (int e = 0; e < 8; ++e) s += v[e];
                        const float mean = wave_sum(s) * (1.0f / 512.0f);
                        float q = 0.f;
#pragma unroll
                        for (int e = 0; e < 8; ++e) { v[e] -= mean; q += v[e] * v[e]; }
                        const float rstd = rsqrtf(wave_sum(q) * (1.0f / 512.0f) + EPSN);
                        u32x4 w; w.x = pk2(v[0] * rstd * bf_lo(gq.x), v[1] * rstd * bf_hi(gq.x)); w.y = pk2(v[2] * rstd * bf_lo(gq.y), v[3] * rstd * bf_hi(gq.y));
                        w.z = pk2(v[4] * rstd * bf_lo(gq.z), v[5] * rstd * bf_hi(gq.z)); w.w = pk2(v[6] * rstd * bf_lo(gq.w), v[7] * rstd * bf_hi(gq.w));
                        if (it < T_ALL * 8) *(u32x4*)(MIX + tok * 4096 + h * 512 + 8 * lane) = w;
                    }
                }
            }
            GRID_SYNC();
            if (PH(7)) {
                PHASE_IDS
                WSB(X, float, WS_X) WSB(XB, bf16_t, WS_XB) WSB(SS, float, WS_SS) WSB(MIX, bf16_t, WS_MIX) WSB(WoutR, bf16_t, WS_WOUTR)
                pg8::EpiRes E{XB, SS};
                for (int blk = bid; blk < 256; blk += G) sample_out_block(lds, MIX, WoutR + (size_t)li * 2048 * 4096, 4096, XB, SS, blk, tid);
                RUN_GEMM(pg8::EpiRes, MIX, WoutR + (size_t)li * 2048 * 4096, T_P, 2048, 4096, E, 0);
            }
            GRID_SYNC();
        }
        for (int rep_ = 0; rep_ < (PH(8) ? REP(8) : 0); ++rep_) {
                PHASE_IDS
            WSB(XQ, bf16_t, WS_XQ) WSB(SS, float, WS_SS) WSB(VT, bf16_t, WS_VT) WSB(XB, bf16_t, WS_XB) WSB(Wxq, bf16_t, WS_WXQ)
            WSB(XQ1, bf16_t, WS_Z)
            for (int sk = 0; sk < 2; ++sk) {
                pg8::EpiZ E{sk ? XQ1 : XQ, 512, SS, 0, 0, 0, 0, -1, VT, T_ALL};
                pg8::Gemm gg{(const pg8::bf16_t*)(XB + sk * 1024), (const pg8::bf16_t*)(Wxq + (size_t)l * 512 * 2048 + sk * 1024), T_ALL, 512, 1024, 2048};
                pg8::StaticOrder SO; SO.init(T_ALL, 512, G, (bid + (sk ? G - 66 : 0)) % G); pg8::gemm_phase<pg8::EpiZ, pg8::StaticOrder, true, true>(lds, gg, SO, E);
            }
        }
        GRID_SYNC();
        for (int rep_ = 0; rep_ < (PH(9) ? REP(9) : 0); ++rep_) {
                PHASE_IDS
            INP(cache_mem_k, 5) INP(cache_mem_v, 6)
            WSB(XQ, bf16_t, WS_XQ) WSB(XQ1, bf16_t, WS_Z) WSB(XO, bf16_t, WS_XO) WSB(MEMKV, bf16_t, WS_MEMKV) WSB(MEMVT, bf16_t, WS_MEMVT) WSB(DUMMY, bf16_t, WS_O)
            LAS float* wl = (LAS float*)(lds + wave * 12288);
            const float* mk = cache_mem_k + (size_t)l * 32 * 256 * 512; const float* mv = cache_mem_v + (size_t)l * 32 * 256 * 512;
            const int hb = G / 2;
            if (bid >= hb) { if (PHS(19)) for (int it = bid - hb; it < 128; it += (G - hb)) xattn_sample_block(lds, XQ, XQ1, mk, mv, XO, it, tid); }
            if (PHS(18)) for (int it = gw; it < 2048; it += NGW) xattn_prompt_item(XQ, XQ1, MEMKV, MEMVT, XO, l, it, lane);
        }
        GRID_SYNC();
        if (PH(10)) {
                PHASE_IDS
            WSB(X, float, WS_X) WSB(XB, bf16_t, WS_XB) WSB(SS, float, WS_SS) WSB(XO, bf16_t, WS_XO) WSB(Wxo, bf16_t, WS_WXO)
            pg8::EpiRes E{XB, SS};
            for (int blk = bid; blk < 256; blk += G) sample_out_block(lds, XO, Wxo + (size_t)l * 2048 * 512, 512, XB, SS, blk, tid);
            RUN_GEMM(pg8::EpiRes, XO, Wxo + (size_t)l * 2048 * 512, T_P, 2048, 512, E, 0);
        }
        GRID_SYNC();
    }
    if (PH(11)) {
                PHASE_IDS
        INP(norm_final, 24) OUTP(out) WSB(X, float, WS_X) WSB(SS, float, WS_SS)
        WSB(XBf, bf16_t, WS_XB)
        for (int m = gw; m < T_ALL; m += NGW) {
            const float sp = (lane < 32) ? SS[(size_t)m * 32 + lane] : 0.f;
            const float rstd = rsqrtf(wave_sum(sp) * (1.0f / 2048.0f) + EPSN);
            const u32x2* xr = (const u32x2*)(XBf + (size_t)m * 2048) + lane; const f32x4* gr_ = (const f32x4*)norm_final + lane;
            f32x4* yr = (f32x4*)(out + OUT_YP + (size_t)m * 2048) + lane;
#pragma unroll
            for (int j = 0; j < 8; ++j) { const u32x2 w = xr[64 * j]; const f32x4 xv = {bf_lo(w.x), bf_hi(w.x), bf_lo(w.y), bf_hi(w.y)}; yr[64 * j] = xv * rstd * gr_[64 * j]; }
        }
    }
}

extern "C" void kernel_launch(void* const* d_in, const int* in_sizes, int n_in, void* d_out, int out_size, void* d_ws, size_t ws_size, hipStream_t stream) {
    static int grid = 0;
    if (grid == 0) {
        if (n_in != 25 || (size_t)out_size != OUT_TOTAL || ws_size < WS_END) {
            fprintf(stderr, "kernel_launch: unexpected shapes: n_in %d out_size %d ws %zu (need %zu)\n", n_in, out_size, ws_size, (size_t)WS_END); grid = -1; return; }
        int dev = 0, cus = 0, per_cu = 0;
        (void)hipGetDevice(&dev);
        (void)hipDeviceGetAttribute(&cus, hipDeviceAttributeMultiprocessorCount, dev);
        if (hipFuncSetAttribute((const void*)hybrid_fwd, hipFuncAttributeMaxDynamicSharedMemorySize, LDS_BYTES) != hipSuccess) { fprintf(stderr, "kernel_launch: hipFuncSetAttribute failed\n"); grid = -1; return; }
        if (hipOccupancyMaxActiveBlocksPerMultiprocessor(&per_cu, (const void*)hybrid_fwd, NTHREADS, LDS_BYTES) != hipSuccess || per_cu < 1) { fprintf(stderr, "kernel_launch: occupancy query gave %d\n", per_cu); per_cu = 1; }
        (void)hipGetLastError();
        grid = cus * 1;
        if (grid <= 0) grid = 256;
    }
    if (grid < 0) return;
    Params p{};
    for (int i = 0; i < 25; ++i) p.in[i] = (const float*)d_in[i];
    p.out = (float*)d_out; p.ws = (unsigned char*)d_ws;
    constexpr int NPHASES = 28;
#if defined(SPLIT_LAUNCHES)
    for (int ph = 0; ph < NPHASES; ++ph) {
        p.ph_lo = ph; p.ph_hi = ph + 1;
        hipLaunchKernelGGL(hybrid_fwd, dim3(grid), dim3(NTHREADS), LDS_BYTES, stream, p);
    }
#else
    p.ph_lo = 0; p.ph_hi = NPHASES;
    if (hipMemsetAsync((char*)d_ws + WS_BAR, 0, 16384, stream) != hipSuccess) { fprintf(stderr, "kernel_launch: memset of the barrier words failed\n"); return; }
    void* args[] = {&p};
    hipError_t e = hipLaunchCooperativeKernel((const void*)hybrid_fwd, dim3(grid), dim3(NTHREADS), args, LDS_BYTES, stream);
    if (e != hipSuccess) fprintf(stderr, "kernel_launch: cooperative launch failed: %s (grid %d)\n", hipGetErrorString(e), grid);
#endif
}
```
